# Optimizing an MI355X kernel written in HIP

```python
import math
import jax, jax.numpy as jnp
from jax import lax
import numpy as np

D_MODEL = 1024
BATCH = 2
SEQ = 8192
DEPTH = 1
DEC_BATCH = 128
DEC_SEQ = 4
PAST_LEN = 16384
PAGE_SIZE = 128

HEAD_DIM = 64
MIX_WIDTH = D_MODEL
ATT_WIDTH = MIX_WIDTH // 2
CONV_DIM = MIX_WIDTH - ATT_WIDTH
N_Q_HEADS = ATT_WIDTH // HEAD_DIM
N_KV_HEADS = 2
GQA_GROUP = N_Q_HEADS // N_KV_HEADS
CONV_GROUPS = CONV_DIM // HEAD_DIM
CONV_WIDTH = 3
WINDOW = 128
BLOCK = 128
N_BUCKETS = 32
MAX_DISTANCE = 128
D_FF = 2816
D_PLE = 256
RMS_EPS = 1e-6
IN_COLS = ATT_WIDTH + 2 * N_KV_HEADS * HEAD_DIM + 3 * CONV_DIM
NEG_INF = -1e30

kernel_name = "hybrid_swa_shortconv_macaron_decoder_step"


def _rms(x, g):
    x32 = x.astype(jnp.float32)
    y = x32 * lax.rsqrt(jnp.mean(x32 * x32, axis=-1, keepdims=True) + RMS_EPS)
    return y.astype(x.dtype) * g


def _swiglu(h, w_gate, w_up, w_down):
    return (jax.nn.silu(h @ w_gate) * (h @ w_up)) @ w_down


def _rel_bucket(dist):
    max_exact = N_BUCKETS // 2
    d = jnp.maximum(dist, 0)
    df = jnp.maximum(d, 1).astype(jnp.float32)
    large = max_exact + (jnp.log(df / max_exact) / math.log(MAX_DISTANCE / max_exact)
                         * (N_BUCKETS - max_exact)).astype(jnp.int32)
    large = jnp.minimum(large, N_BUCKETS - 1)
    return jnp.where(d < max_exact, d, large)


def _rel_bias(table, dist):
    b = table[_rel_bucket(dist)]
    qn, kn = dist.shape
    return jnp.transpose(b, (2, 0, 1)).reshape(N_KV_HEADS, GQA_GROUP, qn, kn)


def _sink_attention(q, k, v, bias, mask, sinks):
    s = jnp.einsum('...qhgd,...khd->...hgqk', q, k).astype(jnp.float32) * (HEAD_DIM ** -0.5)
    s = jnp.where(mask, s + bias.astype(jnp.float32), NEG_INF)
    sink = sinks.astype(jnp.float32)[..., None, None]
    m = jnp.maximum(jnp.max(s, axis=-1, keepdims=True), sink)
    e = jnp.exp(s - m)
    w = e / (jnp.sum(e, axis=-1, keepdims=True) + jnp.exp(sink - m))
    return jnp.einsum('...hgqk,...khd->...qhgd', w.astype(v.dtype), v)


def _attn_prompt(q, k, v, table, sinks):
    B, T = q.shape[:2]
    nb = T // BLOCK
    qb = q.reshape(B, nb, BLOCK, N_KV_HEADS, GQA_GROUP, HEAD_DIM)
    kb = k.reshape(B, nb, BLOCK, N_KV_HEADS, HEAD_DIM)
    vb = v.reshape(B, nb, BLOCK, N_KV_HEADS, HEAD_DIM)
    pad = jnp.zeros_like(kb[:, :1])
    kc = jnp.concatenate([jnp.concatenate([pad, kb[:, :-1]], axis=1), kb], axis=2)
    vc = jnp.concatenate([jnp.concatenate([pad, vb[:, :-1]], axis=1), vb], axis=2)
    qi = jnp.arange(BLOCK)[:, None]
    kj = jnp.arange(2 * BLOCK)[None, :]
    dist = qi + BLOCK - kj
    valid_key = (jnp.arange(nb)[:, None, None] * BLOCK - BLOCK + kj[None]) >= 0
    mask = (dist >= 0)[None] & (dist < WINDOW)[None] & valid_key
    bias = _rel_bias(table, dist)
    o = _sink_attention(qb, kc, vc, bias, mask[None, :, None, None], sinks)
    return o.reshape(B, T, ATT_WIDTH)


def _attn_sample(q, k_new, v_new, k_cache, v_cache, table, sinks):
    Bd, S = q.shape[:2]
    W = k_cache.shape[1]
    kc = jnp.concatenate([k_cache, k_new], axis=1)
    vc = jnp.concatenate([v_cache, v_new], axis=1)
    dist = jnp.arange(S)[:, None] + W - jnp.arange(W + S)[None, :]
    mask = (dist >= 0) & (dist < WINDOW)
    bias = _rel_bias(table, dist)
    qg = q.reshape(Bd, S, N_KV_HEADS, GQA_GROUP, HEAD_DIM)
    o = _sink_attention(qg, kc, vc, bias, mask, sinks)
    return o.reshape(Bd, S, ATT_WIDTH), kc[:, -W:], vc[:, -W:]


def _short_conv(u, buf, w_conv):
    T = u.shape[1]
    full = jnp.concatenate([buf, u], axis=1)
    y = w_conv[0] * full[:, 0:T]
    for j in range(1, CONV_WIDTH):
        y = y + w_conv[j] * full[:, j:j + T]
    return y, full[:, -(CONV_WIDTH - 1):]


def _layer(x, pe, lw, rel_bias, k_cache=None, v_cache=None, conv_buf=None):
    (g1, w1g, w1u, w1d, gm, w_in, qn, kn, sinks, w_conv, w_out,
     g2, w2g, w2u, w2d, gp, wpg, wpp) = lw
    B, T, _ = x.shape
    x = x + 0.5 * _swiglu(_rms(x, g1), w1g, w1u, w1d)
    z = _rms(x, gm) @ w_in
    o1 = ATT_WIDTH
    o2 = o1 + N_KV_HEADS * HEAD_DIM
    o3 = o2 + N_KV_HEADS * HEAD_DIM
    o4 = o3 + CONV_DIM
    o5 = o4 + CONV_DIM
    q = _rms(z[..., :o1].reshape(B, T, N_Q_HEADS, HEAD_DIM), qn)
    k = _rms(z[..., o1:o2].reshape(B, T, N_KV_HEADS, HEAD_DIM), kn)
    v = z[..., o2:o3].reshape(B, T, N_KV_HEADS, HEAD_DIM)
    gate_b = z[..., o3:o4]
    gate_c = z[..., o4:o5]
    h = z[..., o5:]
    sinks_g = sinks.reshape(N_KV_HEADS, GQA_GROUP)
    if k_cache is None:
        att = _attn_prompt(q, k, v, rel_bias, sinks_g)
        w = min(WINDOW, T)
        k_state, v_state = k[:, T - w:], v[:, T - w:]
        conv_buf = jnp.zeros((B, CONV_WIDTH - 1, CONV_DIM), x.dtype)
    else:
        att, k_state, v_state = _attn_sample(q, k, v, k_cache, v_cache, rel_bias, sinks_g)
    cv, conv_state = _short_conv(gate_c * h, conv_buf, w_conv)
    x = x + jnp.concatenate([att, gate_b * cv], axis=-1) @ w_out
    x = x + 0.5 * _swiglu(_rms(x, g2), w2g, w2u, w2d)
    x = x + jax.nn.sigmoid(_rms(x, gp) @ wpg) * (pe @ wpp)
    return x, k_state, v_state, conv_state


def setup_inputs(seed: int = 0) -> dict:
    key = jax.random.key(seed)
    ks = jax.random.split(key, 32)
    f32 = jnp.float32

    def nrm(k, shape, scale):
        return jax.random.normal(k, shape, f32) * scale

    def gain(k, shape):
        return 1.0 + 0.05 * jax.random.normal(k, shape, f32)

    win = min(WINDOW, PAST_LEN)
    D = D_MODEL
    return {
        "x_prompt": nrm(ks[0], (BATCH, SEQ, D), 1.0),
        "x_sample": nrm(ks[1], (DEC_BATCH, DEC_SEQ, D), 1.0),
        "p_prompt": nrm(ks[2], (DEPTH, BATCH, SEQ, D_PLE), 1.0),
        "p_sample": nrm(ks[3], (DEPTH, DEC_BATCH, DEC_SEQ, D_PLE), 1.0),
        "cache_k": nrm(ks[4], (DEPTH, DEC_BATCH, win, N_KV_HEADS, HEAD_DIM), 1.0),
        "cache_v": nrm(ks[5], (DEPTH, DEC_BATCH, win, N_KV_HEADS, HEAD_DIM), 1.0),
        "state_conv": nrm(ks[6], (DEPTH, DEC_BATCH, CONV_WIDTH - 1, CONV_DIM), 1.0),
        "rel_bias": nrm(ks[7], (N_BUCKETS, N_Q_HEADS), 0.5),
        "g_ffn1": gain(ks[8], (DEPTH, D)),
        "w1_gate": nrm(ks[9], (DEPTH, D, D_FF), D ** -0.5),
        "w1_up": nrm(ks[10], (DEPTH, D, D_FF), D ** -0.5),
        "w1_down": nrm(ks[11], (DEPTH, D_FF, D), D_FF ** -0.5),
        "g_mix": gain(ks[12], (DEPTH, D)),
        "w_in": nrm(ks[13], (DEPTH, D, IN_COLS), D ** -0.5),
        "q_norm": gain(ks[14], (DEPTH, HEAD_DIM)),
        "k_norm": gain(ks[15], (DEPTH, HEAD_DIM)),
        "sinks": nrm(ks[16], (DEPTH, N_Q_HEADS), 1.0),
        "w_conv": nrm(ks[17], (DEPTH, CONV_WIDTH, CONV_DIM), CONV_WIDTH ** -0.5),
        "w_out": nrm(ks[18], (DEPTH, MIX_WIDTH, D), MIX_WIDTH ** -0.5),
        "g_ffn2": gain(ks[19], (DEPTH, D)),
        "w2_gate": nrm(ks[20], (DEPTH, D, D_FF), D ** -0.5),
        "w2_up": nrm(ks[21], (DEPTH, D, D_FF), D ** -0.5),
        "w2_down": nrm(ks[22], (DEPTH, D_FF, D), D_FF ** -0.5),
        "g_ple": gain(ks[23], (DEPTH, D)),
        "w_ple_gate": nrm(ks[24], (DEPTH, D, D), D ** -0.5),
        "w_ple_proj": nrm(ks[25], (DEPTH, D_PLE, D), D_PLE ** -0.5),
    }


def reference(x_prompt, x_sample, p_prompt, p_sample, cache_k, cache_v, state_conv, rel_bias,
              g_ffn1, w1_gate, w1_up, w1_down, g_mix, w_in, q_norm, k_norm, sinks, w_conv, w_out,
              g_ffn2, w2_gate, w2_up, w2_down, g_ple, w_ple_gate, w_ple_proj):
    xp, xs = x_prompt, x_sample
    kp_l, vp_l, cp_l, ks_l, vs_l, cs_l = [], [], [], [], [], []
    for i in range(DEPTH):
        lw = (g_ffn1[i], w1_gate[i], w1_up[i], w1_down[i], g_mix[i], w_in[i], q_norm[i], k_norm[i],
              sinks[i], w_conv[i], w_out[i], g_ffn2[i], w2_gate[i], w2_up[i], w2_down[i],
              g_ple[i], w_ple_gate[i], w_ple_proj[i])
        xp, kp, vp, cp = _layer(xp, p_prompt[i], lw, rel_bias)
        xs, ksn, vsn, csn = _layer(xs, p_sample[i], lw, rel_bias,
                                   k_cache=cache_k[i], v_cache=cache_v[i], conv_buf=state_conv[i])
        kp_l.append(kp); vp_l.append(vp); cp_l.append(cp)
        ks_l.append(ksn); vs_l.append(vsn); cs_l.append(csn)
    k_win_prompt = jnp.stack(kp_l)
    v_win_prompt = jnp.stack(vp_l)
    conv_prompt = jnp.stack(cp_l)
    k_win_sample = jnp.stack(ks_l)
    v_win_sample = jnp.stack(vs_l)
    conv_sample = jnp.stack(cs_l)
    return (xp, xs, k_win_prompt, v_win_prompt, conv_prompt, k_win_sample, v_win_sample, conv_sample)
```

```cpp
#include <hip/hip_runtime.h>
#include <cstdio>
#include <cstdint>

constexpr int D = 1024, FF = 2816, NIN = 2304, DPLE = 256;
constexpr int SEQ = 8192, MP = 2 * SEQ, MS = 128 * 4, M = MP + MS;
constexpr float RMS_EPS = 1e-6f;
constexpr float LOG2E = 1.4426950408889634f;
constexpr float QSCALE = 0.125f * LOG2E;
__device__ __forceinline__ float bf_lo(unsigned w) { return __uint_as_float(w << 16); }
__device__ __forceinline__ float bf_hi(unsigned w) { return __uint_as_float(w & 0xffff0000u); }
#define MK_N_LAUNCHES 9
namespace pg8 {
#define PG8_LAS __attribute__((address_space(3)))
typedef unsigned short bf16_t;
typedef short bf16x8 __attribute__((ext_vector_type(8)));
typedef float f32x4 __attribute__((ext_vector_type(4)));
typedef unsigned u32x4 __attribute__((ext_vector_type(4)));
constexpr int BM = 256, BK = 64, HALF = 128, HTB = HALF * BK * 2  , STAGE_BYTES = 8 * HTB, NXCD = 8, WGM = 8;

__host__ __device__ __forceinline__ int lds_byte(int r, int c) { const int st = (r >> 4) * 2 + (c >> 5), rr = r & 15, cc = c & 31, ob = rr * 64 + cc * 2; return st * 1024 + (ob ^ (((ob >> 9) & 1) << 5)); }
__host__ __device__ __forceinline__ void stage_rc(int b, int& R, int& C) { const int st = b / 1024, sb = b % 1024, swz = sb ^ (((sb >> 9) & 1) << 5); R = (st >> 1) * 16 + swz / 64; C = (st & 1) * 32 + (swz % 64) / 2; }
__host__ __device__ __forceinline__ int perm32(int rho) { const int n = rho >> 4, i = rho & 15; return 8 * (i >> 2) + 4 * n + (i & 3); }

struct Unit { int pm, pn; };
struct Gemm { const bf16_t* A; const bf16_t* Bt; int M, N, K; };

struct StaticOrder {
    int nM, nN, nwg, G, c;
    __host__ __device__ void init(int M, int N, int G_, int c_) { nM = M / BM; nN = N / BM; nwg = nM * nN; G = G_; c = c_; }
    __host__ __device__ bool next(int i, Unit& u) const {
        const long L = (long)i * G + c; if (L >= nwg) return false;
        int wgid = (int)L; { const int q = nwg / NXCD, r = nwg % NXCD, xcd = wgid % NXCD, off = wgid / NXCD; wgid = (xcd < r ? xcd * (q + 1) : r * (q + 1) + (xcd - r) * q) + off; }
        const int nig = WGM * nN, gid = wgid / nig, fm = gid * WGM, gsz = (nM - fm) < WGM ? (nM - fm) : WGM;
        u.pm = fm + ((wgid % nig) % gsz); u.pn = (wgid % nig) / gsz; return true;
    }
    __device__ __forceinline__ void a_ready(const Unit&) const {}
    __device__ __forceinline__ void done(const Unit&) const {}
};

__device__ __forceinline__ unsigned cvt_pk_bf16(float lo, float hi) { unsigned r; asm volatile("v_cvt_pk_bf16_f32 %0, %1, %2" : "=v"(r) : "v"(lo), "v"(hi)); return r; }
typedef float f32x2 __attribute__((ext_vector_type(2)));
__device__ __forceinline__ float row_rscale(const float* stats, int row) {
    const f32x4* p = (const f32x4*)(stats + (size_t)row * 16);
    const f32x4 a = p[0], b = p[1], c = p[2], d = p[3];
    const f32x4 s = (a + b) + (c + d);
    const float t = (s[0] + s[1]) + (s[2] + s[3]);
    return __builtin_amdgcn_rsqf(t * (1.0f / 1024.0f) + RMS_EPS);
}

struct EpiStoreBf16 {
    static constexpr bool PERM = true, AFTER_DRAIN = false;
    bf16_t* O; int ldc;
    __device__ __forceinline__ void operator()(const f32x4 (&acc)[2][2][4][2], const Unit& u, int wr, int wc, int fr, int fq) const {
        const int row0 = u.pm * BM + wr * 64 + fr, col0 = u.pn * BM + wc * 32 + 8 * fq;
#pragma unroll
        for (int ai = 0; ai < 2; ++ai)
#pragma unroll
            for (int m = 0; m < 4; ++m) { bf16_t* rowp = O + (size_t)(row0 + ai * HALF + m * 16) * ldc + col0;
#pragma unroll
                for (int bj = 0; bj < 2; ++bj) { const f32x4 v0 = acc[ai][bj][m][0], v1 = acc[ai][bj][m][1];
                    u32x4 w; w.x = cvt_pk_bf16(v0[0], v0[1]); w.y = cvt_pk_bf16(v0[2], v0[3]); w.z = cvt_pk_bf16(v1[0], v1[1]); w.w = cvt_pk_bf16(v1[2], v1[3]);
                    *(u32x4*)(rowp + bj * HALF) = w; } }
    }
};

template <bool NORM> struct EpiSwiglu {
    static constexpr bool PERM = true, AFTER_DRAIN = false;
    bf16_t* O; const float* stats;
    __device__ __forceinline__ void operator()(const f32x4 (&acc)[2][2][4][2], const Unit& u, int wr, int wc, int fr, int fq) const {
        const int row0 = u.pm * BM + wr * 64 + fr, f0 = u.pn * 128 + wc * 32 + 8 * fq;
#pragma unroll
        for (int ai = 0; ai < 2; ++ai)
#pragma unroll
            for (int m = 0; m < 4; ++m) {
                const int row = row0 + ai * HALF + m * 16;
                float r = 1.0f; if (NORM) r = row_rscale(stats, row);
                float o[8];
#pragma unroll
                for (int n = 0; n < 2; ++n)
#pragma unroll
                    for (int e = 0; e < 4; ++e) { const float g = acc[ai][0][m][n][e] * r, up = acc[ai][1][m][n][e] * r;
                        o[n * 4 + e] = g * __builtin_amdgcn_rcpf(1.0f + __builtin_amdgcn_exp2f(-g * LOG2E)) * up; }
                u32x4 w; w.x = cvt_pk_bf16(o[0], o[1]); w.y = cvt_pk_bf16(o[2], o[3]); w.z = cvt_pk_bf16(o[4], o[5]); w.w = cvt_pk_bf16(o[6], o[7]);
                *(u32x4*)(O + (size_t)row * FF + f0) = w;
            }
    }
};

struct EpiResid {
    static constexpr bool PERM = true, AFTER_DRAIN = false;
    const float* srcP; const float* srcS;
    float* out; bf16_t* xb; float* stats; float alpha;
    __device__ __forceinline__ void operator()(const f32x4 (&acc)[2][2][4][2], const Unit& u, int wr, int wc, int fr, int fq) const {
        const int row0 = u.pm * BM + wr * 64 + fr, col0 = u.pn * BM + wc * 32 + 8 * fq;
#pragma unroll
        for (int ai = 0; ai < 2; ++ai)
#pragma unroll
            for (int m = 0; m < 4; ++m) {
                const int row = row0 + ai * HALF + m * 16;
                const float* src = (row < MP) ? srcP + (size_t)row * D : srcS + (size_t)(row - MP) * D;
                float ss = 0.f;
#pragma unroll
                for (int bj = 0; bj < 2; ++bj) { const int c = col0 + bj * HALF;
                    const f32x4 a0 = *(const f32x4*)(src + c), a1 = *(const f32x4*)(src + c + 4);
                    const f32x4 v0 = a0 + acc[ai][bj][m][0] * alpha, v1 = a1 + acc[ai][bj][m][1] * alpha;
                    *(f32x4*)(out + (size_t)row * D + c) = v0; *(f32x4*)(out + (size_t)row * D + c + 4) = v1;
                    u32x4 w; w.x = cvt_pk_bf16(v0[0], v0[1]); w.y = cvt_pk_bf16(v0[2], v0[3]); w.z = cvt_pk_bf16(v1[0], v1[1]); w.w = cvt_pk_bf16(v1[2], v1[3]);
                    *(u32x4*)(xb + (size_t)row * D + c) = w;
                    ss += (v0[0] * v0[0] + v0[1] * v0[1]) + (v0[2] * v0[2] + v0[3] * v0[3]) + (v1[0] * v1[0] + v1[1] * v1[1]) + (v1[2] * v1[2] + v1[3] * v1[3]); }
                ss += __shfl_xor(ss, 16); ss += __shfl_xor(ss, 32);
                if (fq == 0) stats[(size_t)row * 16 + u.pn * 4 + wc] = ss;
            }
    }
};

struct EpiIn {
    static constexpr bool PERM = true, AFTER_DRAIN = false;
    const float* stats; const float* qn; const float* kn;
    bf16_t *Q, *Kb, *Vb, *Gb, *Ub;
    float *kwinP, *vwinP, *convP, *kwinS, *vwinS, *convS;
    __device__ __forceinline__ void operator()(const f32x4 (&acc)[2][2][4][2], const Unit& u, int wr, int wc, int fr, int fq) const {
        const int row0 = u.pm * BM + wr * 64 + fr, pn = u.pn;
        f32x4 gn[2][2];
        if (pn < 3) { const float* gp = (pn < 2) ? qn : kn;
#pragma unroll
            for (int bj = 0; bj < 2; ++bj)
#pragma unroll
                for (int n = 0; n < 2; ++n) gn[bj][n] = *(const f32x4*)(gp + 32 * bj + 8 * fq + 4 * n); }
#pragma unroll
        for (int ai = 0; ai < 2; ++ai)
#pragma unroll
            for (int m = 0; m < 4; ++m) {
                const int row = row0 + ai * HALF + m * 16;
                const float r = row_rscale(stats, row);
                f32x4 z[2][2];
#pragma unroll
                for (int bj = 0; bj < 2; ++bj)
#pragma unroll
                    for (int n = 0; n < 2; ++n) z[bj][n] = acc[ai][bj][m][n] * r;
                if (pn < 3) {
                    const bool isv = (pn == 2 && wc >= 2);
                    if (!isv) {
                        float ss = 0.f;
#pragma unroll
                        for (int bj = 0; bj < 2; ++bj)
#pragma unroll
                            for (int n = 0; n < 2; ++n) ss += (z[bj][n][0] * z[bj][n][0] + z[bj][n][1] * z[bj][n][1]) + (z[bj][n][2] * z[bj][n][2] + z[bj][n][3] * z[bj][n][3]);
                        ss += __shfl_xor(ss, 16); ss += __shfl_xor(ss, 32);
                        float rq = __builtin_amdgcn_rsqf(ss * (1.0f / 64.0f) + RMS_EPS); if (pn < 2) rq *= QSCALE;
#pragma unroll
                        for (int bj = 0; bj < 2; ++bj)
#pragma unroll
                            for (int n = 0; n < 2; ++n) z[bj][n] = z[bj][n] * rq * gn[bj][n];
                    }
                    bf16_t* dst; float* win = nullptr;
                    if (pn < 2) dst = Q + (size_t)row * 512 + (pn * 4 + wc) * 64 + 8 * fq;
                    else { const int kvh = wc & 1; dst = (isv ? Vb : Kb) + (size_t)row * 128 + kvh * 64 + 8 * fq;
                        if (row < MP) { const int t = row & (SEQ - 1); if (t >= SEQ - 128) win = (isv ? vwinP : kwinP) + ((size_t)(((row >> 13) * 128 + (t - (SEQ - 128))) * 2 + kvh)) * 64 + 8 * fq; }
                        else { const int i = row - MP; win = (isv ? vwinS : kwinS) + ((size_t)(((i >> 2) * 128 + 124 + (i & 3)) * 2 + kvh)) * 64 + 8 * fq; } }
#pragma unroll
                    for (int bj = 0; bj < 2; ++bj) { const f32x4 v0 = z[bj][0], v1 = z[bj][1];
                        u32x4 w; w.x = cvt_pk_bf16(v0[0], v0[1]); w.y = cvt_pk_bf16(v0[2], v0[3]); w.z = cvt_pk_bf16(v1[0], v1[1]); w.w = cvt_pk_bf16(v1[2], v1[3]);
                        *(u32x4*)(dst + 32 * bj) = w;
                        if (win) { *(f32x4*)(win + 32 * bj) = v0; *(f32x4*)(win + 32 * bj + 4) = v1; } }
                } else if (pn < 5) {
                    bf16_t* dst = Gb + (size_t)row * 512 + (pn - 3) * 256 + wc * 32 + 8 * fq;
#pragma unroll
                    for (int bj = 0; bj < 2; ++bj) { const f32x4 v0 = z[bj][0], v1 = z[bj][1];
                        u32x4 w; w.x = cvt_pk_bf16(v0[0], v0[1]); w.y = cvt_pk_bf16(v0[2], v0[3]); w.z = cvt_pk_bf16(v1[0], v1[1]); w.w = cvt_pk_bf16(v1[2], v1[3]);
                        *(u32x4*)(dst + bj * HALF) = w; }
                } else {
                    const int f0 = (pn - 5) * 128 + wc * 32 + 8 * fq;
                    const f32x4 v0 = z[0][0] * z[1][0], v1 = z[0][1] * z[1][1];
                    u32x4 w; w.x = cvt_pk_bf16(v0[0], v0[1]); w.y = cvt_pk_bf16(v0[2], v0[3]); w.z = cvt_pk_bf16(v1[0], v1[1]); w.w = cvt_pk_bf16(v1[2], v1[3]);
                    *(u32x4*)(Ub + (size_t)row * 512 + f0) = w;
                    float* cs = nullptr;
                    if (row < MP) { const int t = row & (SEQ - 1); if (t >= SEQ - 2) cs = convP + (size_t)((row >> 13) * 2 + (t - (SEQ - 2))) * 512 + f0; }
                    else { const int i = row - MP; if ((i & 3) >= 2) cs = convS + (size_t)((i >> 2) * 2 + ((i & 3) - 2)) * 512 + f0; }
                    if (cs) { *(f32x4*)cs = v0; *(f32x4*)(cs + 4) = v1; }
                }
            }
    }
};

struct EpiPle {
    static constexpr bool PERM = true, AFTER_DRAIN = false;
    const float* stats; const bf16_t* pp; float* out;
    __device__ __forceinline__ void operator()(const f32x4 (&acc)[2][2][4][2], const Unit& u, int wr, int wc, int fr, int fq) const {
        const int row0 = u.pm * BM + wr * 64 + fr, col0 = u.pn * BM + wc * 32 + 8 * fq;
#pragma unroll
        for (int ai = 0; ai < 2; ++ai)
#pragma unroll
            for (int m = 0; m < 4; ++m) {
                const int row = row0 + ai * HALF + m * 16;
                const float r = row_rscale(stats, row) * LOG2E;
#pragma unroll
                for (int bj = 0; bj < 2; ++bj) { const size_t off = (size_t)row * D + col0 + bj * HALF;
                    const f32x4 x0 = *(const f32x4*)(out + off), x1 = *(const f32x4*)(out + off + 4);
                    const u32x4 pw = *(const u32x4*)(pp + off);
                    const f32x4 p0 = (f32x4){bf_lo(pw.x), bf_hi(pw.x), bf_lo(pw.y), bf_hi(pw.y)}, p1 = (f32x4){bf_lo(pw.z), bf_hi(pw.z), bf_lo(pw.w), bf_hi(pw.w)};
                    f32x4 y0, y1;
#pragma unroll
                    for (int e = 0; e < 4; ++e) { y0[e] = x0[e] + __builtin_amdgcn_rcpf(1.0f + __builtin_amdgcn_exp2f(-acc[ai][bj][m][0][e] * r)) * p0[e];
                                                  y1[e] = x1[e] + __builtin_amdgcn_rcpf(1.0f + __builtin_amdgcn_exp2f(-acc[ai][bj][m][1][e] * r)) * p1[e]; }
                    *(f32x4*)(out + off) = y0; *(f32x4*)(out + off + 4) = y1; }
            }
    }
};

template <class Epi, class Sched, bool ALIGN_EPI = false, bool SP2 = false>
__device__ __forceinline__ void gemm_phase(PG8_LAS unsigned char* lds, const Gemm g, const Sched& S, const Epi& E) {
    const int tid = threadIdx.x, wid = __builtin_amdgcn_readfirstlane(tid >> 6), lane = tid & 63, wr = wid >> 2, wc = wid & 3, fr = lane & 15, fq = lane >> 4;
    const int K = g.K, nt = K / BK;
    unsigned voffA[2], voffB[2];
#pragma unroll
    for (int i = 0; i < 2; ++i) { int R, C; stage_rc(tid * 16 + i * 8192, R, C); const int Rb = Epi::PERM ? ((R & ~31) + perm32(R & 31)) : R;
        voffA[i] = (unsigned)(R * K + C) * 2u; voffB[i] = (unsigned)(Rb * K + C) * 2u; }
    const size_t kstep = (size_t)(BK * 2);
    const size_t hstep = (size_t)HALF * K * 2;
    const size_t tstep = 2 * hstep;
    const unsigned ldsw = (unsigned)wid * 1024u;
    const int aoff = lds_byte(wr * 64 + fr, fq * 8), boff = lds_byte(wc * 32 + fr, fq * 8);
#define PG8_SA(b, h) (((b) * 2 + (h)) * HTB)
#define PG8_SB(b, h) ((4 + (b) * 2 + (h)) * HTB)
#define PG8_STAGE(bufoff, gbase, voff) do { _Pragma("unroll") for (int _i = 0; _i < 2; ++_i) \
        __builtin_amdgcn_global_load_lds((const unsigned*)((const char*)(gbase) + (voff)[_i]), (PG8_LAS unsigned*)(lds + (bufoff) + ldsw + _i * 8192), 16, 0, 0); } while (0)
#define PG8_LDA(dst, b, h) do { _Pragma("unroll") for (int m = 0; m < 4; ++m) _Pragma("unroll") for (int k = 0; k < 2; ++k) dst[m][k] = *(const PG8_LAS bf16x8*)(lds + PG8_SA(b, h) + aoff + m * 2048 + k * 1024); } while (0)
#define PG8_LDB(dst, b, h) do { _Pragma("unroll") for (int n = 0; n < 2; ++n) _Pragma("unroll") for (int k = 0; k < 2; ++k) dst[n][k] = *(const PG8_LAS bf16x8*)(lds + PG8_SB(b, h) + boff + n * 2048 + k * 1024); } while (0)
#define PG8_MMA(ai, bj, At, Bt) do { __builtin_amdgcn_s_setprio(1); _Pragma("unroll") for (int m = 0; m < 4; ++m) _Pragma("unroll") for (int n = 0; n < 2; ++n) _Pragma("unroll") for (int k = 0; k < 2; ++k) \
        acc[ai][bj][m][n] = __builtin_amdgcn_mfma_f32_16x16x32_bf16(Bt[n][k], At[m][k], acc[ai][bj][m][n], 0, 0, 0); __builtin_amdgcn_s_setprio(0); } while (0)
#define PG8_WAIT_V(n) asm volatile("s_waitcnt vmcnt(" #n ")" ::: "memory")
#define PG8_WAIT_L(n) asm volatile("s_waitcnt lgkmcnt(" #n ")" ::: "memory")
#define PG8_BAR __builtin_amdgcn_s_barrier()
#define PG8_SCHED __builtin_amdgcn_sched_barrier(0)
    Unit cur, nxt; int ui = 0;
    if (!S.next(0, cur)) return;
    f32x4 acc[2][2][4][2];
#pragma unroll
    for (int a = 0; a < 2; ++a)
#pragma unroll
        for (int b = 0; b < 2; ++b)
#pragma unroll
            for (int m = 0; m < 4; ++m)
#pragma unroll
                for (int n = 0; n < 2; ++n) acc[a][b][m][n] = (f32x4){0.f, 0.f, 0.f, 0.f};
    bf16x8 At[4][2], B0[2][2], B1[2][2];
    const char* cA = (const char*)g.A + (size_t)cur.pm * tstep; const char* cB = (const char*)g.Bt + (size_t)cur.pn * tstep;
    S.a_ready(cur);
    if constexpr (SP2) {
        PG8_STAGE(PG8_SB(0, 0), cB, voffB); PG8_STAGE(PG8_SB(0, 1), cB + hstep, voffB); PG8_STAGE(PG8_SA(0, 0), cA, voffA); PG8_STAGE(PG8_SA(0, 1), cA + hstep, voffA);
        if (wr == 1) PG8_BAR;
        PG8_WAIT_V(2); PG8_BAR;
        PG8_STAGE(PG8_SB(1, 0), cB + kstep, voffB); PG8_STAGE(PG8_SA(1, 0), cA + kstep, voffA); PG8_STAGE(PG8_SB(1, 1), cB + hstep + kstep, voffB);
        PG8_WAIT_V(6); PG8_BAR;
    } else {
        PG8_STAGE(PG8_SB(0, 0), cB, voffB); PG8_STAGE(PG8_SA(0, 0), cA, voffA); PG8_STAGE(PG8_SB(0, 1), cB + hstep, voffB); PG8_STAGE(PG8_SA(0, 1), cA + hstep, voffA);
        if (wr == 1) PG8_BAR;
        PG8_WAIT_V(4); PG8_BAR;
        PG8_STAGE(PG8_SB(1, 0), cB + kstep, voffB); PG8_STAGE(PG8_SA(1, 0), cA + kstep, voffA); PG8_STAGE(PG8_SB(1, 1), cB + hstep + kstep, voffB);
        PG8_WAIT_V(6); PG8_BAR;
    }
    for (;;) {
        const bool has_next = S.next(ui + 1, nxt);
        const char* nA = has_next ? (const char*)g.A + (size_t)nxt.pm * tstep : cA; const char* nB = has_next ? (const char*)g.Bt + (size_t)nxt.pn * tstep : cB;
        for (int t = 0; t < nt; t += 2) {
            const bool last = (t == nt - 2);
            const char* a1 = cA + (size_t)(t + 1) * kstep;
            const char* a2 = last ? nA : cA + (size_t)(t + 2) * kstep; const char* b2 = last ? nB : cB + (size_t)(t + 2) * kstep;
            const char* a3 = a2 + kstep; const char* b3 = b2 + kstep;
            if (last && has_next) S.a_ready(nxt);
            if constexpr (SP2) {
            PG8_LDB(B0, 0, 0); PG8_LDB(B1, 0, 1); PG8_SCHED; PG8_LDA(At, 0, 0); PG8_STAGE(PG8_SA(1, 1), a1 + hstep, voffA);
            PG8_WAIT_V(8); PG8_WAIT_L(0); PG8_BAR; PG8_MMA(0, 0, At, B0); PG8_MMA(0, 1, At, B1); PG8_BAR; PG8_SCHED;
            PG8_LDA(At, 0, 1); PG8_STAGE(PG8_SB(0, 0), b2, voffB); PG8_STAGE(PG8_SB(0, 1), b2 + hstep, voffB); PG8_STAGE(PG8_SA(0, 0), a2, voffA);
            PG8_WAIT_V(8); PG8_WAIT_L(0); PG8_BAR; PG8_MMA(1, 0, At, B0); PG8_MMA(1, 1, At, B1); PG8_BAR; PG8_SCHED;
            PG8_LDB(B0, 1, 0); PG8_LDB(B1, 1, 1); PG8_SCHED; PG8_LDA(At, 1, 0); PG8_STAGE(PG8_SA(0, 1), a2 + hstep, voffA);
            PG8_WAIT_V(8); PG8_WAIT_L(0); PG8_BAR; PG8_MMA(0, 0, At, B0); PG8_MMA(0, 1, At, B1); PG8_BAR; PG8_SCHED;
            PG8_LDA(At, 1, 1); PG8_STAGE(PG8_SB(1, 0), b3, voffB); PG8_STAGE(PG8_SB(1, 1), b3 + hstep, voffB); PG8_STAGE(PG8_SA(1, 0), a3, voffA);
            PG8_WAIT_V(8); PG8_WAIT_L(0); PG8_BAR; PG8_MMA(1, 0, At, B0); PG8_MMA(1, 1, At, B1); PG8_BAR; PG8_SCHED;
            } else {
            PG8_LDB(B0, 0, 0); PG8_SCHED; PG8_LDA(At, 0, 0); PG8_STAGE(PG8_SA(1, 1), a1 + hstep, voffA);
            PG8_WAIT_L(8); PG8_BAR; PG8_WAIT_L(0); PG8_MMA(0, 0, At, B0); PG8_BAR; PG8_SCHED;
            PG8_LDB(B1, 0, 1); PG8_STAGE(PG8_SB(0, 0), b2, voffB);
            PG8_BAR; PG8_WAIT_L(0); PG8_MMA(0, 1, At, B1); PG8_BAR;
            PG8_LDA(At, 0, 1); PG8_STAGE(PG8_SA(0, 0), a2, voffA);
            PG8_BAR; PG8_WAIT_L(0); PG8_MMA(1, 0, At, B0); PG8_BAR; PG8_SCHED;
            PG8_STAGE(PG8_SB(0, 1), b2 + hstep, voffB);
            PG8_WAIT_V(6); PG8_BAR; PG8_MMA(1, 1, At, B1); PG8_BAR;
            PG8_LDB(B0, 1, 0); PG8_SCHED; PG8_LDA(At, 1, 0); PG8_STAGE(PG8_SA(0, 1), a2 + hstep, voffA);
            PG8_WAIT_L(8); PG8_BAR; PG8_WAIT_L(0); PG8_MMA(0, 0, At, B0); PG8_BAR; PG8_SCHED;
            PG8_LDB(B1, 1, 1); PG8_STAGE(PG8_SB(1, 0), b3, voffB);
            PG8_BAR; PG8_WAIT_L(0); PG8_MMA(0, 1, At, B1); PG8_BAR;
            PG8_LDA(At, 1, 1); PG8_STAGE(PG8_SA(1, 0), a3, voffA);
            PG8_BAR; PG8_WAIT_L(0); PG8_MMA(1, 0, At, B0); PG8_BAR; PG8_SCHED;
            PG8_STAGE(PG8_SB(1, 1), b3 + hstep, voffB);
            PG8_WAIT_V(6); PG8_BAR; PG8_MMA(1, 1, At, B1); PG8_BAR;
            }
        }
        if constexpr (ALIGN_EPI) { if (wr == 0) PG8_BAR; }
        if constexpr (!Epi::AFTER_DRAIN) { E(acc, cur, wr, wc, fr, fq); S.done(cur); }
        if (!has_next) break;
#pragma unroll
        for (int a = 0; a < 2; ++a)
#pragma unroll
            for (int b = 0; b < 2; ++b)
#pragma unroll
                for (int m = 0; m < 4; ++m)
#pragma unroll
                    for (int n = 0; n < 2; ++n) acc[a][b][m][n] = (f32x4){0.f, 0.f, 0.f, 0.f};
        cur = nxt; cA = nA; cB = nB; ++ui;
        if constexpr (ALIGN_EPI) { if (wr == 1) PG8_BAR; }
    }
    PG8_WAIT_V(0);
    if constexpr (!ALIGN_EPI) { if (wr == 0) PG8_BAR; }
    PG8_BAR;
    if constexpr (Epi::AFTER_DRAIN) { E.fused(acc, cur, wr, wc, fr, fq, lds, wid, lane); S.done(cur); }
#undef PG8_SA
#undef PG8_SB
#undef PG8_STAGE
#undef PG8_LDA
#undef PG8_LDB
#undef PG8_MMA
#undef PG8_WAIT_V
#undef PG8_WAIT_L
#undef PG8_BAR
#undef PG8_SCHED
}
}
#define GAS __attribute__((address_space(1)))
#define LAS __attribute__((address_space(3)))
typedef unsigned short bf16;
typedef unsigned v4u __attribute__((ext_vector_type(4)));
typedef float f32x4 __attribute__((ext_vector_type(4)));
typedef short bf16x8 __attribute__((ext_vector_type(8)));
typedef GAS unsigned gu32;
typedef GAS unsigned long long gu64;
#define RLX_AGENT __ATOMIC_RELAXED, __HIP_MEMORY_SCOPE_AGENT
#define LDS_WAIT() asm volatile("s_waitcnt lgkmcnt(0)" ::: "memory")
#define VM_WAIT() asm volatile("s_waitcnt vmcnt(0)" ::: "memory")
__device__ __forceinline__ unsigned long long rt() { return __builtin_amdgcn_s_memrealtime(); }
__device__ __forceinline__ unsigned f2bf(float f) { unsigned u = __builtin_bit_cast(unsigned, f); return (u + 0x7fffu + ((u >> 16) & 1u)) >> 16; }
__device__ __forceinline__ unsigned pk2(float lo, float hi) { return f2bf(lo) | (f2bf(hi) << 16); }

#define XB_TMO      128
#define XB_XCNT(j)  (256  + 64 * (j))
#define XB_XSUB(j)  (1280 + 64 * (j))
#define XB_XGEN(j)  (2304 + 64 * (j))
#define XB_TOP      3328
#define XB_TOPGEN   3392
#define XCD_BAR_WORDS 3456
#define XB_SPIN_CAP (1u << 18)

__device__ __forceinline__ unsigned xb_ld(unsigned* p)              { return __hip_atomic_load(p, __ATOMIC_RELAXED, __HIP_MEMORY_SCOPE_AGENT); }
__device__ __forceinline__ unsigned xb_add(unsigned* p, unsigned v) { return __hip_atomic_fetch_add(p, v, __ATOMIC_RELAXED, __HIP_MEMORY_SCOPE_AGENT); }
__device__ __forceinline__ unsigned xb_xcc_id() { return (unsigned)__builtin_amdgcn_s_getreg((3 << 11) | 20) & 0xFu; }
#define XB_SPIN(cond, bar) do { unsigned _sp = 0; while (cond) { __builtin_amdgcn_s_sleep(1); \
    if ((++_sp & 255u) == 0u) { if (xb_ld(&(bar)[XB_TMO])) break; if (_sp > XB_SPIN_CAP) { atomicAdd(&(bar)[XB_TMO], 1u); break; } } } } while (0)

struct XcdBarrier {
    unsigned* bar; unsigned x;
    volatile LAS unsigned* st;
};

__device__ __forceinline__ XcdBarrier xcd_barrier_post(unsigned* bar, volatile LAS unsigned* st) {
    XcdBarrier b; b.bar = bar; b.x = xb_xcc_id(); b.st = st;
    if (threadIdx.x == 0) (void)xb_add(&bar[XB_XCNT(b.x)], 1u);
    return b;
}
__device__ __forceinline__ void xcd_barrier_complete(unsigned* bar, unsigned x, unsigned& nloc, unsigned& nx) {
    const unsigned G = gridDim.x * gridDim.y * gridDim.z;
    unsigned sum, cnt, mine, sp = 0u;
    for (;;) {
        sum = 0u; cnt = 0u; mine = 0u;
#pragma unroll
        for (unsigned j = 0; j < 16; ++j) { const unsigned c = xb_ld(&bar[XB_XCNT(j)]); sum += c; cnt += (c > 0u) ? 1u : 0u; mine = (j == x) ? c : mine; }
        if (sum == G) break;
        __builtin_amdgcn_s_sleep(1);
        if ((++sp & 255u) == 0u) { if (xb_ld(&bar[XB_TMO])) break; if (sp > XB_SPIN_CAP) { atomicAdd(&bar[XB_TMO], 1u); break; } }
    }
    nloc = mine > 0u ? mine : 1u; nx = cnt > 0u ? cnt : 1u;
}

__device__ __forceinline__ void xcd_barrier(const XcdBarrier& b) {
    asm volatile("s_waitcnt vmcnt(0)" ::: "memory");
    __syncthreads();
    if (threadIdx.x == 0) {
        unsigned* bar = b.bar;
        __builtin_amdgcn_s_waitcnt(0);
        unsigned nloc = b.st[0], nx = b.st[1];
        if (nloc == 0u) { xcd_barrier_complete(bar, b.x, nloc, nx); b.st[0] = nloc; b.st[1] = nx; }
        const unsigned old = xb_add(&bar[XB_XSUB(b.x)], 1u);
        const unsigned gen = old / nloc;
        if (old + 1u == (gen + 1u) * nloc) {
            __builtin_amdgcn_fence(__ATOMIC_RELEASE, "agent");
            asm volatile("s_waitcnt vmcnt(0)" ::: "memory");
            const unsigned og = xb_add(&bar[XB_TOP], 1u);
            const unsigned tg = og / nx;
            if (og + 1u == (tg + 1u) * nx) xb_add(&bar[XB_TOPGEN], 1u);
            else XB_SPIN(xb_ld(&bar[XB_TOPGEN]) == tg, bar);
            __builtin_amdgcn_fence(__ATOMIC_ACQUIRE, "agent");
            xb_add(&bar[XB_XGEN(b.x)], 1u);
            asm volatile("s_waitcnt vmcnt(0)" ::: "memory");
        } else {
            XB_SPIN(xb_ld(&bar[XB_XGEN(b.x)]) == gen, bar);
            __builtin_amdgcn_fence(__ATOMIC_ACQUIRE, "agent");
            asm volatile("s_waitcnt vmcnt(0)" ::: "memory");
        }
    }
    __syncthreads();
}
namespace att {
typedef short bf16x8 __attribute__((ext_vector_type(8)));
typedef short s16x4 __attribute__((ext_vector_type(4)));
typedef float f32x16 __attribute__((ext_vector_type(16)));
typedef float f32x4 __attribute__((ext_vector_type(4)));
typedef unsigned u32x4 __attribute__((ext_vector_type(4)));
typedef unsigned u32x2 __attribute__((ext_vector_type(2)));
typedef unsigned short bf16_t;
#define ATT_LAS __attribute__((address_space(3)))
constexpr int KCH = 4112;
constexpr int VDH = 16384 + 64;
constexpr int L_K = 0, L_V = 8 * KCH, L_BIAS = L_V + 2 * VDH, L_END = L_BIAS + 8 * 128 * 4;
static_assert(L_V % 16 == 0 && L_BIAS % 16 == 0 && L_END <= 131072, "attention LDS map");
__device__ __forceinline__ int crow(int r, int hi) { return (r & 3) + 8 * (r >> 2) + 4 * hi; }
__device__ __forceinline__ unsigned cvtpk(float lo, float hi) { unsigned r; asm volatile("v_cvt_pk_bf16_f32 %0, %1, %2" : "=v"(r) : "v"(lo), "v"(hi)); return r; }
__device__ __forceinline__ s16x4 vtr(const ATT_LAS unsigned char* p) { typedef short v4i16_t __attribute__((ext_vector_type(4))); return __builtin_bit_cast(s16x4, __builtin_amdgcn_ds_read_tr16_b64_v4i16((ATT_LAS v4i16_t*)p)); }

struct Tensors {
    const bf16_t *Q, *Kb, *Vb, *Gb, *Ub, *CK, *CV;
    bf16_t* MIX;
    const float *wconv, *sconv, *sinks, *relb;
};

__device__ __forceinline__ void unit(const Tensors& T, ATT_LAS unsigned char* lds, bool sample, int blk, int kvh) {
    const int tid = threadIdx.x, lane = tid & 63, wid = __builtin_amdgcn_readfirstlane(tid >> 6), r32 = lane & 31, hi = lane >> 5;
    const int R0 = sample ? (MP + blk * 4) : blk * 128;
    const bool prev_valid = sample ? true : ((blk & 63) != 0);
    const int curN = sample ? 4 : 128;
    const bf16_t* prevK = sample ? T.CK + (size_t)blk * 128 * 128 : T.Kb + (size_t)(R0 - 128) * 128;
    const bf16_t* prevV = sample ? T.CV + (size_t)blk * 128 * 128 : T.Vb + (size_t)(R0 - 128) * 128;
    const bf16_t* curK = T.Kb + (size_t)R0 * 128; const bf16_t* curV = T.Vb + (size_t)R0 * 128;
#pragma unroll
    for (int i = 0; i < 4; ++i) {
        const int c = tid + 512 * i, key = c >> 3, ch = c & 7;
        u32x4 kv = (u32x4){0u, 0u, 0u, 0u}, vv = (u32x4){0u, 0u, 0u, 0u};
        if (key < 128) { if (prev_valid) { kv = *(const u32x4*)(prevK + (size_t)key * 128 + kvh * 64 + ch * 8); vv = *(const u32x4*)(prevV + (size_t)key * 128 + kvh * 64 + ch * 8); } }
        else { int kr = key - 128; kr = kr < curN ? kr : curN - 1; kv = *(const u32x4*)(curK + (size_t)kr * 128 + kvh * 64 + ch * 8); vv = *(const u32x4*)(curV + (size_t)kr * 128 + kvh * 64 + ch * 8); }
        *(ATT_LAS u32x4*)(lds + L_K + ch * KCH + key * 16) = kv;
        *(ATT_LAS u32x4*)(lds + L_V + (ch >> 2) * VDH + key * 64 + (ch & 3) * 16) = vv;
    }
    __syncthreads();
    const int nwu = sample ? 4 : 16;
    for (int wu = wid; wu < nwu; wu += 8) {
        const int hq = wu & 3, g = sample ? 0 : (wu >> 2), head = kvh * 4 + hq;
        const int ql = sample ? (r32 < 4 ? r32 : 3) : r32;
        const bf16_t* Qp = T.Q + (size_t)(R0 + 32 * g + ql) * 512 + head * 64 + hi * 8;
        bf16x8 qf[4];
#pragma unroll
        for (int ks = 0; ks < 4; ++ks) qf[ks] = *(const bf16x8*)(Qp + ks * 16);
        f32x16 s[5];
        const ATT_LAS unsigned char* kbase = lds + L_K + hi * KCH + (32 * g + r32) * 16;
#pragma unroll
        for (int t = 0; t < 5; ++t) {
            s[t] = (f32x16){0.f, 0.f, 0.f, 0.f, 0.f, 0.f, 0.f, 0.f, 0.f, 0.f, 0.f, 0.f, 0.f, 0.f, 0.f, 0.f};
#pragma unroll
            for (int ks = 0; ks < 4; ++ks) { const bf16x8 kf = *(const ATT_LAS bf16x8*)(kbase + 2 * ks * KCH + t * 512); s[t] = __builtin_amdgcn_mfma_f32_32x32x16_bf16(kf, qf[ks], s[t], 0, 0, 0); }
        }
        const ATT_LAS float* bt = (const ATT_LAS float*)(lds + L_BIAS) + head * 128;
        const float sink2 = T.sinks[head] * LOG2E;
        float mx = -1e30f;
#pragma unroll
        for (int t = 0; t < 5; ++t)
#pragma unroll
            for (int r = 0; r < 16; ++r) {
                const int cr = crow(r, hi), dist = 128 + ql - 32 * t - cr, kj = 32 * g + 32 * t + cr;
                const bool ok = (dist >= 0) && (dist < 128) && (prev_valid || kj >= 128);
                const float v = ok ? s[t][r] + bt[dist & 127] : -1e30f;
                s[t][r] = v; mx = fmaxf(mx, v);
            }
        mx = fmaxf(mx, __shfl_xor(mx, 32)); mx = fmaxf(mx, sink2);
        float sum = 0.f;
#pragma unroll
        for (int t = 0; t < 5; ++t)
#pragma unroll
            for (int r = 0; r < 16; ++r) { const float p = __builtin_amdgcn_exp2f(s[t][r] - mx); s[t][r] = p; sum += p; }
        sum += __shfl_xor(sum, 32); sum += __builtin_amdgcn_exp2f(sink2 - mx);
        const float rl = 1.0f / sum;
        f32x16 o[2];
        o[0] = (f32x16){0.f, 0.f, 0.f, 0.f, 0.f, 0.f, 0.f, 0.f, 0.f, 0.f, 0.f, 0.f, 0.f, 0.f, 0.f, 0.f}; o[1] = o[0];
        const ATT_LAS unsigned char* vbase = lds + L_V + (32 * g + 4 * hi + ((lane & 15) >> 2)) * 64 + ((lane >> 4) & 1) * 32 + (lane & 3) * 8;
#pragma unroll
        for (int t = 0; t < 5; ++t)
#pragma unroll
            for (int ks = 0; ks < 2; ++ks) {
                u32x4 pw; pw.x = cvtpk(s[t][8 * ks + 0], s[t][8 * ks + 1]); pw.y = cvtpk(s[t][8 * ks + 2], s[t][8 * ks + 3]); pw.z = cvtpk(s[t][8 * ks + 4], s[t][8 * ks + 5]); pw.w = cvtpk(s[t][8 * ks + 6], s[t][8 * ks + 7]);
                const bf16x8 pf = __builtin_bit_cast(bf16x8, pw);
#pragma unroll
                for (int dt = 0; dt < 2; ++dt) {
                    const ATT_LAS unsigned char* vp = vbase + dt * VDH + (32 * t + 16 * ks) * 64;
                    const s16x4 lo = vtr(vp), hh = vtr(vp + 512);
                    const bf16x8 vf = (bf16x8){lo[0], lo[1], lo[2], lo[3], hh[0], hh[1], hh[2], hh[3]};
                    o[dt] = __builtin_amdgcn_mfma_f32_32x32x16_bf16(vf, pf, o[dt], 0, 0, 0);
                }
            }
        if (!sample || r32 < 4) {
            bf16_t* Op = T.MIX + (size_t)(R0 + 32 * g + ql) * 1024 + head * 64 + 4 * hi;
#pragma unroll
            for (int dt = 0; dt < 2; ++dt)
#pragma unroll
                for (int i = 0; i < 4; ++i) { u32x2 w; w.x = cvtpk(o[dt][4 * i] * rl, o[dt][4 * i + 1] * rl); w.y = cvtpk(o[dt][4 * i + 2] * rl, o[dt][4 * i + 3] * rl);
                    *(u32x2*)(Op + 32 * dt + 8 * i) = w; }
        }
    }
    {
        const int cc = tid & 31, c0 = 256 * kvh + 8 * cc, rg = tid >> 5;
        float w0[8], w1[8], w2[8];
#pragma unroll
        for (int e = 0; e < 8; ++e) { w0[e] = T.wconv[c0 + e]; w1[e] = T.wconv[512 + c0 + e]; w2[e] = T.wconv[1024 + c0 + e]; }
#define ldu(row, u) do { const u32x4 w_ = *(const u32x4*)(T.Ub + (size_t)(row) * 512 + c0); \
            u[0] = bf_lo(w_.x); u[1] = bf_hi(w_.x); u[2] = bf_lo(w_.y); u[3] = bf_hi(w_.y); u[4] = bf_lo(w_.z); u[5] = bf_hi(w_.z); u[6] = bf_lo(w_.w); u[7] = bf_hi(w_.w); } while (0)
        if (!sample) {
            float um2[8], um1[8], u0[8];
            const int ra = R0 + 8 * rg;
            const bool seq_start = ((blk & 63) == 0) && (rg == 0);
            if (seq_start) {
#pragma unroll
                for (int e = 0; e < 8; ++e) { um2[e] = 0.f; um1[e] = 0.f; } }
            else { ldu(ra - 2, um2); ldu(ra - 1, um1); }
#pragma unroll
            for (int j = 0; j < 8; ++j) {
                const int row = ra + j; ldu(row, u0);
                const u32x4 gw = *(const u32x4*)(T.Gb + (size_t)row * 512 + c0);
                const float gb[8] = {bf_lo(gw.x), bf_hi(gw.x), bf_lo(gw.y), bf_hi(gw.y), bf_lo(gw.z), bf_hi(gw.z), bf_lo(gw.w), bf_hi(gw.w)};
                float y[8];
#pragma unroll
                for (int e = 0; e < 8; ++e) { y[e] = gb[e] * (w0[e] * um2[e] + w1[e] * um1[e] + w2[e] * u0[e]); um2[e] = um1[e]; um1[e] = u0[e]; }
                u32x4 w; w.x = cvtpk(y[0], y[1]); w.y = cvtpk(y[2], y[3]); w.z = cvtpk(y[4], y[5]); w.w = cvtpk(y[6], y[7]);
                *(u32x4*)(T.MIX + (size_t)row * 1024 + 512 + c0) = w;
            }
        } else if (rg < 4) {
            const int row = R0 + rg;
            float ua[3][8];
#pragma unroll
            for (int k = 0; k < 3; ++k) { const int ss = rg - 2 + k;
                if (ss >= 0) ldu(R0 + ss, ua[k]);
                else { const float* sp = T.sconv + (size_t)(blk * 2 + (ss + 2)) * 512 + c0;
#pragma unroll
                    for (int e = 0; e < 8; ++e) ua[k][e] = sp[e]; } }
            const u32x4 gw = *(const u32x4*)(T.Gb + (size_t)row * 512 + c0);
            const float gb[8] = {bf_lo(gw.x), bf_hi(gw.x), bf_lo(gw.y), bf_hi(gw.y), bf_lo(gw.z), bf_hi(gw.z), bf_lo(gw.w), bf_hi(gw.w)};
            float y[8];
#pragma unroll
            for (int e = 0; e < 8; ++e) y[e] = gb[e] * (w0[e] * ua[0][e] + w1[e] * ua[1][e] + w2[e] * ua[2][e]);
            u32x4 w; w.x = cvtpk(y[0], y[1]); w.y = cvtpk(y[2], y[3]); w.z = cvtpk(y[4], y[5]); w.w = cvtpk(y[6], y[7]);
            *(u32x4*)(T.MIX + (size_t)row * 1024 + 512 + c0) = w;
        }
    }
#undef ldu
    __syncthreads();
}
}

constexpr int NWAVES = 8;
#ifndef MK_N_LAUNCHES
#define MK_N_LAUNCHES 1
#endif
constexpr int NPHASE = 9;
constexpr int N_LAUNCHES = MK_N_LAUNCHES;
static_assert(N_LAUNCHES == 1 || N_LAUNCHES == NPHASE, "MK_N_LAUNCHES is 1 or 9");

constexpr size_t MiB = 1u << 20;
constexpr size_t WS_CTL = 0, CTL_ZERO_BYTES = 64 * 1024;
constexpr size_t WS_W1GU = 2 * MiB, WS_W1D = 13 * MiB, WS_WIN = 19 * MiB, WS_WOUT = 24 * MiB, WS_W2GU = 26 * MiB, WS_W2D = 37 * MiB, WS_WPG = 43 * MiB, WS_WPP = 45 * MiB;
constexpr size_t STATS_BYTES = (size_t)M * 16 * 4;
constexpr size_t WS_STATS = 46 * MiB;
constexpr size_t WS_CK = 50 * MiB, WS_CV = 54 * MiB;
constexpr size_t WS_PEB = 58 * MiB;
constexpr size_t WS_XB = 67 * MiB;
constexpr size_t WS_KB = 100 * MiB, WS_VB = 105 * MiB;
constexpr size_t WS_PP = 110 * MiB;
constexpr size_t WS_ACT = 143 * MiB;
constexpr size_t WS_QB = 143 * MiB, WS_GB = WS_QB + (size_t)M * 512 * 2, WS_UB = WS_GB + (size_t)M * 512 * 2, WS_MIX = WS_UB + (size_t)M * 512 * 2;
constexpr size_t WS_END = 234 * MiB;
static_assert(WS_W1GU + (size_t)2 * FF * D * 2 <= WS_W1D && WS_W1D + (size_t)D * FF * 2 <= WS_WIN && WS_WIN + (size_t)NIN * D * 2 <= WS_WOUT && WS_WOUT + (size_t)D * D * 2 <= WS_W2GU
              && WS_W2GU + (size_t)2 * FF * D * 2 <= WS_W2D && WS_W2D + (size_t)D * FF * 2 <= WS_WPG && WS_WPG + (size_t)D * D * 2 <= WS_WPP && WS_WPP + (size_t)D * DPLE * 2 <= WS_STATS
              && WS_STATS + 3 * STATS_BYTES <= WS_CK && WS_PEB + (size_t)M * DPLE * 2 <= WS_XB && WS_XB + (size_t)M * D * 2 <= WS_KB && WS_KB + (size_t)M * 128 * 2 <= WS_VB
              && WS_VB + (size_t)M * 128 * 2 <= WS_PP && WS_PP + (size_t)M * D * 2 <= WS_ACT && WS_ACT + (size_t)M * FF * 2 <= WS_END && WS_MIX + (size_t)M * D * 2 <= WS_END, "d_ws map");
constexpr int CW_BAR = 4096;
constexpr size_t O_Y = 0, O_KWP = (size_t)M * D, O_VWP = O_KWP + 2 * 128 * 128, O_CVP = O_VWP + 2 * 128 * 128, O_KWS = O_CVP + 2 * 2 * 512, O_VWS = O_KWS + (size_t)128 * 128 * 128,
                 O_CVS = O_VWS + (size_t)128 * 128 * 128, O_END = O_CVS + 128 * 2 * 512;
constexpr int RING_OFF = 0, RING_BYTES = 131072;
constexpr int LDSCTL_OFF = RING_BYTES, MISC_OFF = LDSCTL_OFF + 320;
constexpr int LDS_BYTES = 147456;
static_assert(MISC_OFF + 128 <= LDS_BYTES, "LDS map");

struct Args { const float* in[26]; float* out; unsigned char* ws; int ph_lo, ph_hi, li, pad; };
typedef const __attribute__((address_space(4))) Args* KArgs;
__device__ __forceinline__ KArgs kargs() { KArgs p = (KArgs)__builtin_amdgcn_kernarg_segment_ptr(); asm volatile("" : "+s"(p)); return p; }
struct Frame {
    LAS unsigned char* lds;
    volatile LAS unsigned* MISC;
    gu32* ctl;
    int tid, lane, wave;
    int vcu, G;
};

__device__ __forceinline__ float wave_sum(float v) {
#pragma unroll
    for (int o = 1; o < 64; o <<= 1) v += __shfl_xor(v, o);
    return v;
}
__device__ __forceinline__ void p0_transpose_item(const float* W, int N, const float* gain, bf16* WT, int KT, int dst_row0, LAS float* scr, int k0, int n0, int lane) {
#pragma unroll 8
    for (int i = 0; i < 32; ++i) { const int kk = 2 * i + (lane >> 5); float v = W[(size_t)(k0 + kk) * N + n0 + (lane & 31)]; if (gain) v *= gain[k0 + kk]; scr[kk * 33 + (lane & 31)] = v; }
    LDS_WAIT(); asm volatile("" ::: "memory");
    const int c = lane & 7;
#pragma unroll
    for (int j = 0; j < 4; ++j) { const int n = (lane >> 3) + 8 * j; const LAS float* s = scr + (8 * c) * 33 + n;
        v4u o; o.x = pk2(s[0 * 33], s[1 * 33]); o.y = pk2(s[2 * 33], s[3 * 33]); o.z = pk2(s[4 * 33], s[5 * 33]); o.w = pk2(s[6 * 33], s[7 * 33]);
        *(GAS v4u*)(WT + (size_t)(dst_row0 + n) * KT + k0 + 8 * c) = o; }
    LDS_WAIT(); asm volatile("" ::: "memory");
}
__device__ __forceinline__ int map_swiglu(int n0, int up) { return 256 * (n0 >> 7) + 128 * up + (n0 & 127); }
__device__ __forceinline__ int map_in(int c0) {
    if (c0 < 512) { const int head = c0 >> 6, bj = (c0 >> 5) & 1; return 256 * (head >> 2) + 128 * bj + 32 * (head & 3); }
    if (c0 < 768) { const int t = c0 - 512, hv = t >> 6, bj = (t >> 5) & 1; return 512 + 128 * bj + 32 * hv; }
    if (c0 < 1280) return c0;
    if (c0 < 1792) { const int f = c0 - 1280; return 256 * (5 + (f >> 7)) + (f & 127); }
    { const int f = c0 - 1792; return 256 * (5 + (f >> 7)) + 128 + (f & 127); }
}
__device__ __forceinline__ void p0_prologue(Frame& F, KArgs Ap) {
    unsigned char* ws = Ap->ws;
    LAS float* scr = (LAS float*)(F.lds + RING_OFF + F.wave * 16384);
    const int gw = F.vcu * NWAVES + F.wave, NGW = F.G * NWAVES;
    constexpr int I_GU = (D / 64) * (FF / 32), I_DN = (FF / 64) * (D / 32), I_IN = (D / 64) * (NIN / 32), I_SQ = (D / 64) * (D / 32), I_PP = (DPLE / 64) * (D / 32);
    constexpr int NITEMS = 4 * I_GU + 2 * I_DN + I_IN + 2 * I_SQ + I_PP;
    for (int it = gw; it < NITEMS; it += NGW) {
        int r = it;
        const float* W; const float* gain = nullptr; bf16* WT; int K, N, mode;
        if (r < I_GU) { W = Ap->in[9]; WT = (bf16*)(ws + WS_W1GU); K = D; N = FF; mode = 1; }
        else if ((r -= I_GU) < I_GU) { W = Ap->in[10]; WT = (bf16*)(ws + WS_W1GU); K = D; N = FF; mode = 2; }
        else if ((r -= I_GU) < I_DN) { W = Ap->in[11]; WT = (bf16*)(ws + WS_W1D); K = FF; N = D; mode = 0; }
        else if ((r -= I_DN) < I_IN) { W = Ap->in[13]; gain = Ap->in[12]; WT = (bf16*)(ws + WS_WIN); K = D; N = NIN; mode = 3; }
        else if ((r -= I_IN) < I_SQ) { W = Ap->in[18]; WT = (bf16*)(ws + WS_WOUT); K = D; N = D; mode = 0; }
        else if ((r -= I_SQ) < I_GU) { W = Ap->in[20]; gain = Ap->in[19]; WT = (bf16*)(ws + WS_W2GU); K = D; N = FF; mode = 1; }
        else if ((r -= I_GU) < I_GU) { W = Ap->in[21]; gain = Ap->in[19]; WT = (bf16*)(ws + WS_W2GU); K = D; N = FF; mode = 2; }
        else if ((r -= I_GU) < I_DN) { W = Ap->in[22]; WT = (bf16*)(ws + WS_W2D); K = FF; N = D; mode = 0; }
        else if ((r -= I_DN) < I_SQ) { W = Ap->in[24]; gain = Ap->in[23]; WT = (bf16*)(ws + WS_WPG); K = D; N = D; mode = 0; }
        else { r -= I_SQ; W = Ap->in[25]; WT = (bf16*)(ws + WS_WPP); K = DPLE; N = D; mode = 0; }
        const int nblk = N / 32, kb = r / nblk, nb = r % nblk, k0 = 64 * kb, n0 = 32 * nb;
        const int dst = mode == 0 ? n0 : mode == 1 ? map_swiglu(n0, 0) : mode == 2 ? map_swiglu(n0, 1) : map_in(n0);
        p0_transpose_item(W, N, gain, WT, K, dst, scr, k0, n0, F.lane);
    }
    {
        const float* g1 = Ap->in[8]; bf16* XB = (bf16*)(ws + WS_XB);
        f32x4 gv[4];
#pragma unroll
        for (int j = 0; j < 4; ++j) gv[j] = ((const GAS f32x4*)g1)[64 * j + F.lane];
        for (int m = gw; m < M; m += NGW) {
            const float* xrow = (m < MP) ? Ap->in[0] + (size_t)m * D : Ap->in[1] + (size_t)(m - MP) * D;
            const GAS f32x4* xr = (const GAS f32x4*)xrow + F.lane;
            f32x4 v[4]; float s = 0.f;
#pragma unroll
            for (int j = 0; j < 4; ++j) { v[j] = xr[64 * j]; s += (v[j].x * v[j].x + v[j].y * v[j].y) + (v[j].z * v[j].z + v[j].w * v[j].w); }
            const float rstd = 1.f / sqrtf(wave_sum(s) * (1.f / D) + RMS_EPS);
            GAS unsigned long long* o8 = (GAS unsigned long long*)(XB + (size_t)m * D) + F.lane;
#pragma unroll
            for (int j = 0; j < 4; ++j) { const f32x4 o = v[j] * rstd * gv[j]; o8[64 * j] = (unsigned long long)pk2(o.x, o.y) | ((unsigned long long)pk2(o.z, o.w) << 32); }
        }
    }
    {
        const int gt = F.vcu * (NWAVES * 64) + F.tid, NT = F.G * NWAVES * 64;
        bf16* PEB = (bf16*)(ws + WS_PEB);
        constexpr int NPE = M * DPLE / 8, NPEP = MP * DPLE / 8;
        for (int i = gt; i < NPE; i += NT) {
            const float* src = (i < NPEP) ? Ap->in[2] + (size_t)i * 8 : Ap->in[3] + (size_t)(i - NPEP) * 8;
            const f32x4 a = *(const GAS f32x4*)src, b = *(const GAS f32x4*)(src + 4);
            v4u o; o.x = pk2(a.x, a.y); o.y = pk2(a.z, a.w); o.z = pk2(b.x, b.y); o.w = pk2(b.z, b.w);
            *(GAS v4u*)(PEB + (size_t)i * 8) = o;
        }
        constexpr int NC = 128 * 128 * 128 / 8;
        for (int i = gt; i < 2 * NC; i += NT) {
            const int which = i >= NC, j = which ? i - NC : i;
            const float* src = Ap->in[4 + which] + (size_t)j * 8;
            const f32x4 a = *(const GAS f32x4*)src, b = *(const GAS f32x4*)(src + 4);
            v4u o; o.x = pk2(a.x, a.y); o.y = pk2(a.z, a.w); o.z = pk2(b.x, b.y); o.w = pk2(b.z, b.w);
            *(GAS v4u*)((bf16*)(ws + (which ? WS_CV : WS_CK)) + (size_t)j * 8) = o;
            const int w = (j >> 4) & 127;
            if (w >= 4) { float* dst = Ap->out + (which ? O_VWS : O_KWS) + (size_t)j * 8 - 512; *(GAS f32x4*)dst = a; *(GAS f32x4*)(dst + 4) = b; }
        }
    }
}

__constant__ unsigned char c_bucket[128] = {0, 1, 2, 3, 4, 5, 6, 7, 8, 9, 10, 11, 12, 13, 14, 15, 16, 16, 16, 17, 17, 18, 18, 18, 19, 19, 19, 20, 20, 20, 20, 21, 21, 21, 21, 22, 22, 22, 22, 22, 23, 23, 23, 23, 23, 23, 24, 24, 24, 24, 24, 24,
    25, 25, 25, 25, 25, 25, 25, 26, 26, 26, 26, 26, 26, 26, 26, 27, 27, 27, 27, 27, 27, 27, 27, 27, 27, 28, 28, 28, 28, 28, 28, 28, 28, 28, 28, 29, 29, 29, 29, 29, 29, 29, 29, 29, 29, 29, 29, 30, 30, 30, 30, 30, 30, 30, 30, 30, 30, 30, 30, 30, 30,
    31, 31, 31, 31, 31, 31, 31, 31, 31, 31, 31, 31, 31, 31, 31};

__global__ void __launch_bounds__(NWAVES * 64, 2) mk_fwd(Args args) {
    extern __shared__ __attribute__((aligned(16))) unsigned char lds[];
    Frame F;
    F.lds = (LAS unsigned char*)lds;
    F.MISC = (volatile LAS unsigned*)(F.lds + MISC_OFF);
    F.tid = threadIdx.x; F.lane = F.tid & 63; F.wave = __builtin_amdgcn_readfirstlane(F.tid >> 6);
    F.G = gridDim.x; { const int bx = blockIdx.x; F.vcu = (F.G % 8 == 0) ? (bx % 8) * (F.G / 8) + bx / 8 : bx; }
    F.ctl = (gu32*)(args.ws + WS_CTL);
    for (int u = F.tid; u < (LDS_BYTES - LDSCTL_OFF) / 4; u += NWAVES * 64) ((LAS unsigned*)(F.lds + LDSCTL_OFF))[u] = 0u;
    __syncthreads();
    XcdBarrier bar; bar.bar = (unsigned*)(F.ctl + CW_BAR); bar.x = 0; bar.st = nullptr;
    if (N_LAUNCHES == 1) bar = xcd_barrier_post((unsigned*)(F.ctl + CW_BAR), F.MISC + 8);
#define GRID_BAR() do { if (N_LAUNCHES == 1) xcd_barrier(bar); } while (0)
    const int lo = args.ph_lo, hi = args.ph_hi;
#define IN(k) (lo <= (k) && (k) < hi)
#define BOTH(k) (IN(k) && IN((k) + 1))
#define PHASE_ARGS() KArgs KA = kargs(); unsigned char* const ws = KA->ws; float* const out = KA->out; (void)out; \
    bf16* const XB = (bf16*)(ws + WS_XB); bf16* const ACT = (bf16*)(ws + WS_ACT); bf16* const PP = (bf16*)(ws + WS_PP); (void)XB; (void)ACT; (void)PP; \
    float* const ST1 = (float*)(ws + WS_STATS); float* const ST2 = (float*)(ws + WS_STATS + STATS_BYTES); float* const ST3 = (float*)(ws + WS_STATS + 2 * STATS_BYTES); (void)ST1; (void)ST2; (void)ST3

    if (IN(0)) { p0_prologue(F, kargs()); if (BOTH(0)) GRID_BAR(); }

    if (IN(1)) { PHASE_ARGS();
        { pg8::Gemm g{XB, (const bf16*)(ws + WS_W1GU), M, 2 * FF, D}; pg8::StaticOrder S; S.init(M, 2 * FF, F.G, (int)blockIdx.x);
          pg8::EpiSwiglu<false> E{ACT, nullptr};
          pg8::gemm_phase<pg8::EpiSwiglu<false>, pg8::StaticOrder, true, true>(F.lds + RING_OFF, g, S, E); }
        { int kpp = DPLE; asm volatile("" : "+s"(kpp));
          pg8::Gemm g{(const bf16*)(ws + WS_PEB), (const bf16*)(ws + WS_WPP), M, D, kpp}; pg8::StaticOrder S; S.init(M, D, F.G, (int)(F.G - 1 - blockIdx.x));
          pg8::EpiStoreBf16 E{PP, D};
          pg8::gemm_phase<pg8::EpiStoreBf16, pg8::StaticOrder, true, true>(F.lds + RING_OFF, g, S, E); }
        if (BOTH(1)) GRID_BAR();
    }
    if (IN(2)) { PHASE_ARGS();
        pg8::Gemm g{ACT, (const bf16*)(ws + WS_W1D), M, D, FF}; pg8::StaticOrder S; S.init(M, D, F.G, (int)blockIdx.x);
        pg8::EpiResid E{KA->in[0], KA->in[1], out, XB, ST1, 0.5f};
        pg8::gemm_phase<pg8::EpiResid, pg8::StaticOrder, true, true>(F.lds + RING_OFF, g, S, E);
        if (BOTH(2)) GRID_BAR();
    }
    if (IN(3)) { PHASE_ARGS();
        pg8::Gemm g{XB, (const bf16*)(ws + WS_WIN), M, NIN, D}; pg8::StaticOrder S; S.init(M, NIN, F.G, (int)blockIdx.x);
        pg8::EpiIn E{ST1, KA->in[14], KA->in[15], (bf16*)(ws + WS_QB), (bf16*)(ws + WS_KB), (bf16*)(ws + WS_VB), (bf16*)(ws + WS_GB), (bf16*)(ws + WS_UB),
                     out + O_KWP, out + O_VWP, out + O_CVP, out + O_KWS, out + O_VWS, out + O_CVS};
        pg8::gemm_phase<pg8::EpiIn, pg8::StaticOrder, true, true>(F.lds + RING_OFF, g, S, E);
        if (BOTH(3)) GRID_BAR();
    }
    if (IN(4)) { PHASE_ARGS();
        { LAS float* bt = (LAS float*)(F.lds + att::L_BIAS); const float* relb = KA->in[7];
          for (int i = F.tid; i < 8 * 128; i += NWAVES * 64) { const int h = i >> 7, d = i & 127; bt[i] = relb[c_bucket[d] * 8 + h] * LOG2E; } }
        const att::Tensors T{(const bf16*)(ws + WS_QB), (const bf16*)(ws + WS_KB), (const bf16*)(ws + WS_VB), (const bf16*)(ws + WS_GB), (const bf16*)(ws + WS_UB), (const bf16*)(ws + WS_CK), (const bf16*)(ws + WS_CV),
                             (bf16*)(ws + WS_MIX), KA->in[17], KA->in[6], KA->in[16], KA->in[7]};
        for (int i = blockIdx.x; i < 512; i += F.G) { const bool sample = i >= 256; const int j = i & 255; att::unit(T, F.lds, sample, j >> 1, j & 1); }
        if (BOTH(4)) GRID_BAR();
    }
    if (IN(5)) { PHASE_ARGS();
        pg8::Gemm g{(const bf16*)(ws + WS_MIX), (const bf16*)(ws + WS_WOUT), M, D, D}; pg8::StaticOrder S; S.init(M, D, F.G, (int)blockIdx.x);
        pg8::EpiResid E{out, out + (size_t)MP * D, out, XB, ST2, 1.0f};
        pg8::gemm_phase<pg8::EpiResid, pg8::StaticOrder, true, true>(F.lds + RING_OFF, g, S, E);
        if (BOTH(5)) GRID_BAR();
    }
    if (IN(6)) { PHASE_ARGS();
        pg8::Gemm g{XB, (const bf16*)(ws + WS_W2GU), M, 2 * FF, D}; pg8::StaticOrder S; S.init(M, 2 * FF, F.G, (int)blockIdx.x);
        pg8::EpiSwiglu<true> E{ACT, ST2};
        pg8::gemm_phase<pg8::EpiSwiglu<true>, pg8::StaticOrder, true, true>(F.lds + RING_OFF, g, S, E);
        if (BOTH(6)) GRID_BAR();
    }
    if (IN(7)) { PHASE_ARGS();
        pg8::Gemm g{ACT, (const bf16*)(ws + WS_W2D), M, D, FF}; pg8::StaticOrder S; S.init(M, D, F.G, (int)blockIdx.x);
        pg8::EpiResid E{out, out + (size_t)MP * D, out, XB, ST3, 0.5f};
        pg8::gemm_phase<pg8::EpiResid, pg8::StaticOrder, true, true>(F.lds + RING_OFF, g, S, E);
        if (BOTH(7)) GRID_BAR();
    }
    if (IN(8)) { PHASE_ARGS();
        pg8::Gemm g{XB, (const bf16*)(ws + WS_WPG), M, D, D}; pg8::StaticOrder S; S.init(M, D, F.G, (int)blockIdx.x);
        pg8::EpiPle E{ST3, PP, out};
        pg8::gemm_phase<pg8::EpiPle, pg8::StaticOrder, true, true>(F.lds + RING_OFF, g, S, E);
    }
#undef IN
#undef BOTH
#undef GRID_BAR
#undef PHASE_ARGS
}

extern "C" void kernel_launch(void* const* d_in, const int* in_sizes, int n_in, void* d_out, int out_size, void* d_ws, size_t ws_size, hipStream_t stream) {
    static int grid = 0;
    if (grid == 0) {
        if (n_in != 26 || in_sizes[0] != MP * D || (size_t)out_size != O_END || ws_size < WS_END) { fprintf(stderr, "kernel_launch: unexpected shapes: n_in %d, in0 %d, out %d, ws %zu; nothing launched\n", n_in, n_in > 0 ? in_sizes[0] : -1, out_size, ws_size); grid = -1; return; }
        int dev = 0, cus = 0, per_cu = 0;
        if (hipGetDevice(&dev) != hipSuccess || hipDeviceGetAttribute(&cus, hipDeviceAttributeMultiprocessorCount, dev) != hipSuccess) { fprintf(stderr, "kernel_launch: hipGetDevice / hipDeviceGetAttribute failed\n"); grid = -1; return; }
        if (hipFuncSetAttribute((const void*)mk_fwd, hipFuncAttributeMaxDynamicSharedMemorySize, LDS_BYTES) != hipSuccess) { fprintf(stderr, "kernel_launch: hipFuncSetAttribute failed\n"); grid = -1; return; }
        if (hipOccupancyMaxActiveBlocksPerMultiprocessor(&per_cu, (const void*)mk_fwd, NWAVES * 64, LDS_BYTES) != hipSuccess || per_cu < 1)
            fprintf(stderr, "kernel_launch: note: the occupancy query reports %d workgroups per CU\n", per_cu);
        (void)hipGetLastError();
        grid = cus;
    }
    if (grid < 0) return;
    if (hipMemsetAsync((char*)d_ws + WS_CTL, 0, CTL_ZERO_BYTES, stream) != hipSuccess) { fprintf(stderr, "kernel_launch: hipMemsetAsync failed\n"); return; }
    Args a{};
    for (int i = 0; i < 26; ++i) a.in[i] = (const float*)d_in[i];
    a.out = (float*)d_out; a.ws = (unsigned char*)d_ws;
    for (int li = 0; li < N_LAUNCHES; ++li) {
        a.ph_lo = (N_LAUNCHES == 1) ? 0 : li; a.ph_hi = (N_LAUNCHES == 1) ? NPHASE : li + 1; a.li = li;
        hipLaunchKernelGGL(mk_fwd, dim3(grid), dim3(NWAVES * 64), LDS_BYTES, stream, a);
        const hipError_t le = hipPeekAtLastError();
        if (le != hipSuccess) { fprintf(stderr, "kernel_launch: launch %d failed: %s\n", li, hipGetErrorName(le)); break; }
    }
}
```

```cpp
#include <hip/hip_runtime.h>
#include <cstdio>
#include <cstdint>

constexpr int D = 1024, FF = 2816, NIN = 2304, DPLE = 256;
constexpr int FFP = FF + 64;
constexpr int SEQ = 8192, MP = 2 * SEQ, MS = 128 * 4, M = MP + MS;
constexpr float RMS_EPS = 1e-6f;
constexpr float LOG2E = 1.4426950408889634f;
constexpr float QSCALE = 0.125f * LOG2E;
__device__ __forceinline__ float bf_lo(unsigned w) { return __uint_as_float(w << 16); }
__device__ __forceinline__ float bf_hi(unsigned w) { return __uint_as_float(w & 0xffff0000u); }
#define MK_N_LAUNCHES 1
namespace pg8 {
#define PG8_LAS __attribute__((address_space(3)))
typedef unsigned short bf16_t;
typedef short bf16x8 __attribute__((ext_vector_type(8)));
typedef float f32x4 __attribute__((ext_vector_type(4)));
typedef unsigned u32x4 __attribute__((ext_vector_type(4)));
constexpr int BM = 256, BK = 64, HALF = 128, HTB = HALF * BK * 2  , STAGE_BYTES = 8 * HTB, NXCD = 8, WGM = 8;

__host__ __device__ __forceinline__ int lds_byte(int r, int c) { const int st = (r >> 4) * 2 + (c >> 5), rr = r & 15, cc = c & 31, ob = rr * 64 + cc * 2; return st * 1024 + (ob ^ (((ob >> 9) & 1) << 5)); }
__host__ __device__ __forceinline__ void stage_rc(int b, int& R, int& C) { const int st = b / 1024, sb = b % 1024, swz = sb ^ (((sb >> 9) & 1) << 5); R = (st >> 1) * 16 + swz / 64; C = (st & 1) * 32 + (swz % 64) / 2; }
__host__ __device__ __forceinline__ int perm32(int rho) { const int n = rho >> 4, i = rho & 15; return 8 * (i >> 2) + 4 * n + (i & 3); }

struct Unit { int pm, pn; };
struct Gemm { const bf16_t* A; const bf16_t* Bt; int M, N, K, ld; };

struct StaticOrder {
    int nM, nN, nwg, G, c;
    __host__ __device__ void init(int M, int N, int G_, int c_) { nM = M / BM; nN = N / BM; nwg = nM * nN; G = G_; c = c_; }
    __host__ __device__ bool next(int i, Unit& u) const {
        const long L = (long)i * G + c; if (L >= nwg) return false;
        int wgid = (int)L; { const int q = nwg / NXCD, r = nwg % NXCD, xcd = wgid % NXCD, off = wgid / NXCD; wgid = (xcd < r ? xcd * (q + 1) : r * (q + 1) + (xcd - r) * q) + off; }
        const int nig = WGM * nN, gid = wgid / nig, fm = gid * WGM, gsz = (nM - fm) < WGM ? (nM - fm) : WGM;
        u.pm = fm + ((wgid % nig) % gsz); u.pn = (wgid % nig) / gsz; return true;
    }
    __device__ __forceinline__ void a_ready(const Unit&) const {}
    __device__ __forceinline__ void done(const Unit&) const {}
};

__device__ __forceinline__ unsigned cvt_pk_bf16(float lo, float hi) { unsigned r; asm volatile("v_cvt_pk_bf16_f32 %0, %1, %2" : "=v"(r) : "v"(lo), "v"(hi)); return r; }
typedef float f32x2 __attribute__((ext_vector_type(2)));
__device__ __forceinline__ float row_rscale(const float* stats, int row) {
    const f32x4* p = (const f32x4*)(stats + (size_t)row * 16);
    const f32x4 a = p[0], b = p[1], c = p[2], d = p[3];
    const f32x4 s = (a + b) + (c + d);
    const float t = (s[0] + s[1]) + (s[2] + s[3]);
    return __builtin_amdgcn_rsqf(t * (1.0f / 1024.0f) + RMS_EPS);
}
__device__ __forceinline__ float row_rscale_lds(const PG8_LAS unsigned char* stab, int rowp, int fq) {
    const f32x4 a = *(const PG8_LAS f32x4*)(stab + rowp * 64 + fq * 16);
    float t = (a[0] + a[1]) + (a[2] + a[3]);
    t += __shfl_xor(t, 16); t += __shfl_xor(t, 32);
    return __builtin_amdgcn_rsqf(t * (1.0f / 1024.0f) + RMS_EPS);
}
__device__ __forceinline__ float row_rscale4(const float* stats, int row, int fq) {
    const f32x4 a = *(const f32x4*)(stats + (size_t)row * 16 + 4 * fq);
    float t = (a[0] + a[1]) + (a[2] + a[3]);
    t += __shfl_xor(t, 16); t += __shfl_xor(t, 32);
    return __builtin_amdgcn_rsqf(t * (1.0f / 1024.0f) + RMS_EPS);
}

struct EpiStoreBf16 {
    static constexpr bool PERM = true, AFTER_DRAIN = false, STATS_LDS = false, STRIP = false;
    bf16_t* O; int ldc;
    __device__ __forceinline__ void operator()(const f32x4 (&acc)[2][2][4][2], const Unit& u, int wr, int wc, int fr, int fq) const {
        const int row0 = u.pm * BM + wr * 64 + fr, col0 = u.pn * BM + wc * 32 + 8 * fq;
#pragma unroll
        for (int ai = 0; ai < 2; ++ai)
#pragma unroll
            for (int m = 0; m < 4; ++m) { bf16_t* rowp = O + (size_t)(row0 + ai * HALF + m * 16) * ldc + col0;
#pragma unroll
                for (int bj = 0; bj < 2; ++bj) { const f32x4 v0 = acc[ai][bj][m][0], v1 = acc[ai][bj][m][1];
                    u32x4 w; w.x = cvt_pk_bf16(v0[0], v0[1]); w.y = cvt_pk_bf16(v0[2], v0[3]); w.z = cvt_pk_bf16(v1[0], v1[1]); w.w = cvt_pk_bf16(v1[2], v1[3]);
                    *(u32x4*)(rowp + bj * HALF) = w; } }
    }
};

template <bool NORM> struct EpiSwiglu {
    static constexpr bool PERM = true, AFTER_DRAIN = false, STATS_LDS = NORM, STRIP = false;
    bf16_t* O; const float* stats; const PG8_LAS unsigned char* stab;
    __device__ __forceinline__ void operator()(const f32x4 (&acc)[2][2][4][2], const Unit& u, int wr, int wc, int fr, int fq) const {
        const int row0 = u.pm * BM + wr * 64 + fr, f0 = u.pn * 128 + wc * 32 + 8 * fq;
#pragma unroll
        for (int ai = 0; ai < 2; ++ai)
#pragma unroll
            for (int m = 0; m < 4; ++m) {
                const int row = row0 + ai * HALF + m * 16;
                float r = 1.0f, rinv = 1.0f; if (NORM) { r = row_rscale_lds(stab, row - u.pm * BM, fq); rinv = __builtin_amdgcn_rcpf(r); }
                float o[8];
#pragma unroll
                for (int n = 0; n < 2; ++n)
#pragma unroll
                    for (int e = 0; e < 4; ++e) { float g = acc[ai][0][m][n][e]; const float up = acc[ai][1][m][n][e];
                        if (NORM) g *= r;
                        const float ex = __builtin_amdgcn_exp2f(-g);
                        const float den = NORM ? __builtin_fmaf(ex, rinv, rinv) : 1.0f + ex;
                        o[n * 4 + e] = g * __builtin_amdgcn_rcpf(den) * up; }
                u32x4 w; w.x = cvt_pk_bf16(o[0], o[1]); w.y = cvt_pk_bf16(o[2], o[3]); w.z = cvt_pk_bf16(o[4], o[5]); w.w = cvt_pk_bf16(o[6], o[7]);
                *(u32x4*)(O + (size_t)row * FFP + f0) = w;
            }
    }
};

template <bool FROM_H1> struct EpiResid {
    static constexpr bool PERM = true, AFTER_DRAIN = false, STATS_LDS = false, STRIP = true;
    const float* rms; const float* g;
    bf16_t* xb; float* stats; float alpha;
    __device__ __forceinline__ void strip(const f32x4 (&accS)[2], const Unit& u, int wr, int wc, int fr, int fq) const {
        const int row = MP + 8 * u.pm + fr, col = u.pn * BM + wr * HALF + wc * 32 + 8 * fq;
        float ss = 0.f;
        if (fr < 8) {
            const u32x4 p = *(const u32x4*)(xb + (size_t)row * D + col);
            f32x4 a0 = (f32x4){bf_lo(p.x), bf_hi(p.x), bf_lo(p.y), bf_hi(p.y)}, a1 = (f32x4){bf_lo(p.z), bf_hi(p.z), bf_lo(p.w), bf_hi(p.w)};
            if (FROM_H1) { const float rr = rms[row]; const f32x4 g0 = *(const f32x4*)(g + col), g1 = *(const f32x4*)(g + col + 4);
                a0 = a0 * rr * (f32x4){1.0f / g0[0], 1.0f / g0[1], 1.0f / g0[2], 1.0f / g0[3]}; a1 = a1 * rr * (f32x4){1.0f / g1[0], 1.0f / g1[1], 1.0f / g1[2], 1.0f / g1[3]}; }
            const f32x4 v0 = a0 + accS[0] * alpha, v1 = a1 + accS[1] * alpha;
            u32x4 w; w.x = cvt_pk_bf16(v0[0], v0[1]); w.y = cvt_pk_bf16(v0[2], v0[3]); w.z = cvt_pk_bf16(v1[0], v1[1]); w.w = cvt_pk_bf16(v1[2], v1[3]);
            *(u32x4*)(xb + (size_t)row * D + col) = w;
            ss = (v0[0] * v0[0] + v0[1] * v0[1]) + (v0[2] * v0[2] + v0[3] * v0[3]) + (v1[0] * v1[0] + v1[1] * v1[1]) + (v1[2] * v1[2] + v1[3] * v1[3]);
        }
        ss += __shfl_xor(ss, 16); ss += __shfl_xor(ss, 32);
        if (fr < 8 && fq == 0) atomicAdd(stats + (size_t)row * 16 + u.pn * 4 + wc, ss);
    }
    __device__ __forceinline__ void operator()(const f32x4 (&acc)[2][2][4][2], const Unit& u, int wr, int wc, int fr, int fq) const {
        const int row0 = u.pm * BM + wr * 64 + fr, col0 = u.pn * BM + wc * 32 + 8 * fq;
        f32x4 ig[2][2];
        if (FROM_H1) {
#pragma unroll
            for (int bj = 0; bj < 2; ++bj)
#pragma unroll
                for (int n = 0; n < 2; ++n) { const f32x4 gv = *(const f32x4*)(g + col0 + bj * HALF + 4 * n); ig[bj][n] = (f32x4){1.0f / gv[0], 1.0f / gv[1], 1.0f / gv[2], 1.0f / gv[3]}; } }
#pragma unroll
        for (int ai = 0; ai < 2; ++ai) {
            u32x4 pw[4][2]; float rr[4];
#pragma unroll
            for (int m = 0; m < 4; ++m) { const int row = row0 + ai * HALF + m * 16;
                rr[m] = 1.0f; if (FROM_H1) rr[m] = rms[row];
#pragma unroll
                for (int bj = 0; bj < 2; ++bj) pw[m][bj] = *(const u32x4*)(xb + (size_t)row * D + col0 + bj * HALF); }
#pragma unroll
            for (int m = 0; m < 4; ++m) {
                const int row = row0 + ai * HALF + m * 16;
                float ss = 0.f;
#pragma unroll
                for (int bj = 0; bj < 2; ++bj) { const int c = col0 + bj * HALF; const u32x4 p = pw[m][bj];
                    f32x4 a0 = (f32x4){bf_lo(p.x), bf_hi(p.x), bf_lo(p.y), bf_hi(p.y)}, a1 = (f32x4){bf_lo(p.z), bf_hi(p.z), bf_lo(p.w), bf_hi(p.w)};
                    if (FROM_H1) { a0 = a0 * rr[m] * ig[bj][0]; a1 = a1 * rr[m] * ig[bj][1]; }
                    const f32x4 v0 = a0 + acc[ai][bj][m][0] * alpha, v1 = a1 + acc[ai][bj][m][1] * alpha;
                    u32x4 w; w.x = cvt_pk_bf16(v0[0], v0[1]); w.y = cvt_pk_bf16(v0[2], v0[3]); w.z = cvt_pk_bf16(v1[0], v1[1]); w.w = cvt_pk_bf16(v1[2], v1[3]);
                    *(u32x4*)(xb + (size_t)row * D + c) = w;
                    ss += (v0[0] * v0[0] + v0[1] * v0[1]) + (v0[2] * v0[2] + v0[3] * v0[3]) + (v1[0] * v1[0] + v1[1] * v1[1]) + (v1[2] * v1[2] + v1[3] * v1[3]); }
                ss += __shfl_xor(ss, 16); ss += __shfl_xor(ss, 32);
                if (fq == 0) stats[(size_t)row * 16 + u.pn * 4 + wc] = ss;
            }
        }
    }
};

struct EpiIn {
    static constexpr bool PERM = true, AFTER_DRAIN = false, STATS_LDS = true, STRIP = false;
    const float* stats; const PG8_LAS unsigned char* stab; const float* qn; const float* kn;
    bf16_t *Q, *Kb, *Vb, *Gb, *Ub;
    float *kwinP, *vwinP, *convP, *kwinS, *vwinS, *convS;
    __device__ __forceinline__ void operator()(const f32x4 (&acc)[2][2][4][2], const Unit& u, int wr, int wc, int fr, int fq) const {
        const int row0 = u.pm * BM + wr * 64 + fr, pn = u.pn;
        f32x4 gn[2][2];
        if (pn < 3) { const float* gp = (pn < 2) ? qn : kn;
#pragma unroll
            for (int bj = 0; bj < 2; ++bj)
#pragma unroll
                for (int n = 0; n < 2; ++n) gn[bj][n] = *(const f32x4*)(gp + 32 * bj + 8 * fq + 4 * n); }
#pragma unroll
        for (int ai = 0; ai < 2; ++ai)
#pragma unroll
            for (int m = 0; m < 4; ++m) {
                const int row = row0 + ai * HALF + m * 16;
                const float r = row_rscale_lds(stab, row - u.pm * BM, fq);
                f32x4 z[2][2];
#pragma unroll
                for (int bj = 0; bj < 2; ++bj)
#pragma unroll
                    for (int n = 0; n < 2; ++n) z[bj][n] = acc[ai][bj][m][n] * r;
                if (pn < 3) {
                    const bool isv = (pn == 2 && wc >= 2);
                    if (!isv) {
                        float ss = 0.f;
#pragma unroll
                        for (int bj = 0; bj < 2; ++bj)
#pragma unroll
                            for (int n = 0; n < 2; ++n) ss += (z[bj][n][0] * z[bj][n][0] + z[bj][n][1] * z[bj][n][1]) + (z[bj][n][2] * z[bj][n][2] + z[bj][n][3] * z[bj][n][3]);
                        ss += __shfl_xor(ss, 16); ss += __shfl_xor(ss, 32);
                        float rq = __builtin_amdgcn_rsqf(ss * (1.0f / 64.0f) + RMS_EPS); if (pn < 2) rq *= QSCALE;
#pragma unroll
                        for (int bj = 0; bj < 2; ++bj)
#pragma unroll
                            for (int n = 0; n < 2; ++n) z[bj][n] = z[bj][n] * rq * gn[bj][n];
                    }
                    bf16_t* dst; float* win = nullptr;
                    if (pn < 2) dst = Q + (size_t)row * 512 + (pn * 4 + wc) * 64 + 8 * fq;
                    else { const int kvh = wc & 1; dst = (isv ? Vb : Kb) + (size_t)row * 128 + kvh * 64 + 8 * fq;
                        if (row < MP) { const int t = row & (SEQ - 1); if (t >= SEQ - 128) win = (isv ? vwinP : kwinP) + ((size_t)(((row >> 13) * 128 + (t - (SEQ - 128))) * 2 + kvh)) * 64 + 8 * fq; }
                        else { const int i = row - MP; win = (isv ? vwinS : kwinS) + ((size_t)(((i >> 2) * 128 + 124 + (i & 3)) * 2 + kvh)) * 64 + 8 * fq; } }
#pragma unroll
                    for (int bj = 0; bj < 2; ++bj) { const f32x4 v0 = z[bj][0], v1 = z[bj][1];
                        u32x4 w; w.x = cvt_pk_bf16(v0[0], v0[1]); w.y = cvt_pk_bf16(v0[2], v0[3]); w.z = cvt_pk_bf16(v1[0], v1[1]); w.w = cvt_pk_bf16(v1[2], v1[3]);
                        *(u32x4*)(dst + 32 * bj) = w;
                        if (win) { *(f32x4*)(win + 32 * bj) = v0; *(f32x4*)(win + 32 * bj + 4) = v1; } }
                } else if (pn < 5) {
                    bf16_t* dst = Gb + (size_t)row * 512 + (pn - 3) * 256 + wc * 32 + 8 * fq;
#pragma unroll
                    for (int bj = 0; bj < 2; ++bj) { const f32x4 v0 = z[bj][0], v1 = z[bj][1];
                        u32x4 w; w.x = cvt_pk_bf16(v0[0], v0[1]); w.y = cvt_pk_bf16(v0[2], v0[3]); w.z = cvt_pk_bf16(v1[0], v1[1]); w.w = cvt_pk_bf16(v1[2], v1[3]);
                        *(u32x4*)(dst + bj * HALF) = w; }
                } else {
                    const int f0 = (pn - 5) * 128 + wc * 32 + 8 * fq;
                    const f32x4 v0 = z[0][0] * z[1][0], v1 = z[0][1] * z[1][1];
                    u32x4 w; w.x = cvt_pk_bf16(v0[0], v0[1]); w.y = cvt_pk_bf16(v0[2], v0[3]); w.z = cvt_pk_bf16(v1[0], v1[1]); w.w = cvt_pk_bf16(v1[2], v1[3]);
                    *(u32x4*)(Ub + (size_t)row * 512 + f0) = w;
                    float* cs = nullptr;
                    if (row < MP) { const int t = row & (SEQ - 1); if (t >= SEQ - 2) cs = convP + (size_t)((row >> 13) * 2 + (t - (SEQ - 2))) * 512 + f0; }
                    else { const int i = row - MP; if ((i & 3) >= 2) cs = convS + (size_t)((i >> 2) * 2 + ((i & 3) - 2)) * 512 + f0; }
                    if (cs) { *(f32x4*)cs = v0; *(f32x4*)(cs + 4) = v1; }
                }
            }
    }
};

struct EpiPle {
    static constexpr bool PERM = true, AFTER_DRAIN = false, STATS_LDS = true, STRIP = true;
    const float* stats; const PG8_LAS unsigned char* stab; const bf16_t* pp; const bf16_t* xb; float* out;
    __device__ __forceinline__ void strip(const f32x4 (&accS)[2], const Unit& u, int wr, int wc, int fr, int fq) const {
        if (fr < 8) {
            const int row = MP + 8 * u.pm + fr, col = u.pn * BM + wr * HALF + wc * 32 + 8 * fq;
            const float r = row_rscale(stats, row) * LOG2E;
            const size_t off = (size_t)row * D + col;
            const u32x4 x = *(const u32x4*)(xb + off), p = *(const u32x4*)(pp + off);
            const f32x4 x0 = (f32x4){bf_lo(x.x), bf_hi(x.x), bf_lo(x.y), bf_hi(x.y)}, x1 = (f32x4){bf_lo(x.z), bf_hi(x.z), bf_lo(x.w), bf_hi(x.w)};
            const f32x4 p0 = (f32x4){bf_lo(p.x), bf_hi(p.x), bf_lo(p.y), bf_hi(p.y)}, p1 = (f32x4){bf_lo(p.z), bf_hi(p.z), bf_lo(p.w), bf_hi(p.w)};
            f32x4 y0, y1;
#pragma unroll
            for (int e = 0; e < 4; ++e) { y0[e] = x0[e] + __builtin_amdgcn_rcpf(1.0f + __builtin_amdgcn_exp2f(-accS[0][e] * r)) * p0[e];
                                          y1[e] = x1[e] + __builtin_amdgcn_rcpf(1.0f + __builtin_amdgcn_exp2f(-accS[1][e] * r)) * p1[e]; }
            *(f32x4*)(out + off) = y0; *(f32x4*)(out + off + 4) = y1;
        }
    }
    __device__ __forceinline__ void operator()(const f32x4 (&acc)[2][2][4][2], const Unit& u, int wr, int wc, int fr_, int fq_) const {
        int fr = fr_, fq = fq_; asm volatile("" : "+v"(fr), "+v"(fq));
        const int row0 = u.pm * BM + wr * 64 + fr, col0 = u.pn * BM + wc * 32 + 8 * fq;
#pragma unroll
        for (int am = 0; am < 4; ++am) { const int ai = am >> 1;
            u32x4 xw[4][2], pw[4][2];
#pragma unroll
            for (int m = 2 * (am & 1); m < 2 * (am & 1) + 2; ++m)
#pragma unroll
                for (int bj = 0; bj < 2; ++bj) { const size_t off = (size_t)(row0 + ai * HALF + m * 16) * D + col0 + bj * HALF; xw[m][bj] = *(const u32x4*)(xb + off); pw[m][bj] = *(const u32x4*)(pp + off); }
#pragma unroll
            for (int m = 2 * (am & 1); m < 2 * (am & 1) + 2; ++m) {
                const int row = row0 + ai * HALF + m * 16;
                const float r = row_rscale_lds(stab, row - u.pm * BM, fq) * LOG2E;
#pragma unroll
                for (int bj = 0; bj < 2; ++bj) { const size_t off = (size_t)row * D + col0 + bj * HALF; const u32x4 x = xw[m][bj], p = pw[m][bj];
                    const f32x4 x0 = (f32x4){bf_lo(x.x), bf_hi(x.x), bf_lo(x.y), bf_hi(x.y)}, x1 = (f32x4){bf_lo(x.z), bf_hi(x.z), bf_lo(x.w), bf_hi(x.w)};
                    const f32x4 p0 = (f32x4){bf_lo(p.x), bf_hi(p.x), bf_lo(p.y), bf_hi(p.y)}, p1 = (f32x4){bf_lo(p.z), bf_hi(p.z), bf_lo(p.w), bf_hi(p.w)};
                    f32x4 y0, y1;
#pragma unroll
                    for (int e = 0; e < 4; ++e) { y0[e] = x0[e] + __builtin_amdgcn_rcpf(1.0f + __builtin_amdgcn_exp2f(-acc[ai][bj][m][0][e] * r)) * p0[e];
                                                  y1[e] = x1[e] + __builtin_amdgcn_rcpf(1.0f + __builtin_amdgcn_exp2f(-acc[ai][bj][m][1][e] * r)) * p1[e]; }
                    *(f32x4*)(out + off) = y0; *(f32x4*)(out + off + 4) = y1; }
            }
        }
    }
};

template <class Epi, class Sched, bool ALIGN_EPI = false, bool SP2 = false>
__device__ __forceinline__ void gemm_phase(PG8_LAS unsigned char* lds, const Gemm g, const Sched& S, const Epi& E) {
    int tid_ = threadIdx.x; asm volatile("" : "+v"(tid_));
    const int tid = tid_, wid = __builtin_amdgcn_readfirstlane(tid >> 6), lane = tid & 63, wr = wid >> 2, wc = wid & 3, fr = lane & 15, fq = lane >> 4;
    const int K = g.K, nt = K / BK, LD = g.ld;
    unsigned voffA[2], voffB[2];
#pragma unroll
    for (int i = 0; i < 2; ++i) { int R, C; stage_rc(tid * 16 + i * 8192, R, C); const int Rb = Epi::PERM ? ((R & ~31) + perm32(R & 31)) : R;
        voffA[i] = (unsigned)(R * LD + C) * 2u; voffB[i] = (unsigned)(Rb * LD + C) * 2u; }
    const unsigned kstep = (unsigned)(BK * 2);
    const unsigned hstep = (unsigned)HALF * LD * 2;
    const unsigned tstep = 2 * hstep;
    const unsigned ldsw = (unsigned)wid * 1024u;
    const int aoff = lds_byte(wr * 64 + fr, fq * 8), boff = lds_byte(wc * 32 + fr, fq * 8);
#define PG8_SA(b, h) (((b) * 2 + (h)) * HTB)
#define PG8_SB(b, h) ((4 + (b) * 2 + (h)) * HTB)
    const __amdgpu_buffer_rsrc_t rA = __builtin_amdgcn_make_buffer_rsrc((void*)g.A, 0, -1, 0x00020000), rB = __builtin_amdgcn_make_buffer_rsrc((void*)g.Bt, 0, -1, 0x00020000);
#define PG8_STAGE(bufoff, goff, voff, rs) do { _Pragma("unroll") for (int _i = 0; _i < 2; ++_i) \
        __builtin_amdgcn_raw_ptr_buffer_load_lds(rs, (PG8_LAS unsigned*)(lds + (bufoff) + ldsw + _i * 8192), 16, (int)(voff)[_i], (int)(goff), 0, 0); } while (0)
#define PG8_LDA(dst, b, h) do { _Pragma("unroll") for (int m = 0; m < 4; ++m) _Pragma("unroll") for (int k = 0; k < 2; ++k) dst[m][k] = *(const PG8_LAS bf16x8*)(lds + PG8_SA(b, h) + aoff + m * 2048 + k * 1024); } while (0)
#define PG8_LDB(dst, b, h) do { _Pragma("unroll") for (int n = 0; n < 2; ++n) _Pragma("unroll") for (int k = 0; k < 2; ++k) dst[n][k] = *(const PG8_LAS bf16x8*)(lds + PG8_SB(b, h) + boff + n * 2048 + k * 1024); } while (0)
#define PG8_MMA(ai, bj, At, Bt) do { __builtin_amdgcn_s_setprio(1); _Pragma("unroll") for (int m = 0; m < 4; ++m) _Pragma("unroll") for (int n = 0; n < 2; ++n) _Pragma("unroll") for (int k = 0; k < 2; ++k) \
        acc[ai][bj][m][n] = __builtin_amdgcn_mfma_f32_16x16x32_bf16(Bt[n][k], At[m][k], acc[ai][bj][m][n], 0, 0, 0); __builtin_amdgcn_s_setprio(0); } while (0)
#define PG8_WAIT_V(n) asm volatile("s_waitcnt vmcnt(" #n ")" ::: "memory")
#define PG8_WAIT_L(n) asm volatile("s_waitcnt lgkmcnt(" #n ")" ::: "memory")
#define PG8_BAR __builtin_amdgcn_s_barrier()
#define PG8_SCHED __builtin_amdgcn_sched_barrier(0)
    constexpr int STRIP_OFF = STAGE_BYTES + 16384;
    const int srow_ = 8 * (wid & 1) + (lane >> 3);
    const unsigned voffS = (unsigned)(srow_ * LD) * 2u + (unsigned)(((lane & 7) ^ (srow_ & 7)) * 16);
    const int soff0 = fr * 128 + ((fq ^ (fr & 7)) << 4);
#define PG8_STAGES(b, goff) do { if constexpr (Epi::STRIP) { if (wid < 2) __builtin_amdgcn_raw_ptr_buffer_load_lds(rA, (PG8_LAS unsigned*)(lds + STRIP_OFF + (b) * 2048 + wid * 1024), 16, (int)voffS, (int)(goff), 0, 0); } } while (0)
#define PG8_LDS(b) do { if constexpr (Epi::STRIP) { Sf[0] = *(const PG8_LAS bf16x8*)(lds + STRIP_OFF + (b) * 2048 + soff0); Sf[1] = *(const PG8_LAS bf16x8*)(lds + STRIP_OFF + (b) * 2048 + (soff0 ^ 64)); } } while (0)
#define PG8_MMAS() do { if constexpr (Epi::STRIP) { if (wr == 0) { _Pragma("unroll") for (int n = 0; n < 2; ++n) _Pragma("unroll") for (int k = 0; k < 2; ++k) accS[n] = __builtin_amdgcn_mfma_f32_16x16x32_bf16(B0[n][k], Sf[k], accS[n], 0, 0, 0); } \
        else { _Pragma("unroll") for (int n = 0; n < 2; ++n) _Pragma("unroll") for (int k = 0; k < 2; ++k) accS[n] = __builtin_amdgcn_mfma_f32_16x16x32_bf16(B1[n][k], Sf[k], accS[n], 0, 0, 0); } } } while (0)
    static_assert(!Epi::STRIP || SP2, "the sample-row strip lives in the SP2 loop");
    Unit cur, nxt; int ui = 0;
    if (!S.next(0, cur)) return;
    f32x4 accS[2] = {(f32x4){0.f, 0.f, 0.f, 0.f}, (f32x4){0.f, 0.f, 0.f, 0.f}}; bf16x8 Sf[2];
    f32x4 acc[2][2][4][2];
#pragma unroll
    for (int a = 0; a < 2; ++a)
#pragma unroll
        for (int b = 0; b < 2; ++b)
#pragma unroll
            for (int m = 0; m < 4; ++m)
#pragma unroll
                for (int n = 0; n < 2; ++n) acc[a][b][m][n] = (f32x4){0.f, 0.f, 0.f, 0.f};
    bf16x8 At[4][2], B0[2][2], B1[2][2];
    unsigned cA = (unsigned)cur.pm * tstep, cB = (unsigned)cur.pn * tstep;
    unsigned cS = (unsigned)(MP + 8 * cur.pm) * LD * 2;
    S.a_ready(cur);
    if constexpr (SP2) {
        PG8_STAGE(PG8_SB(0, 0), cB, voffB, rB); PG8_STAGE(PG8_SB(0, 1), cB + hstep, voffB, rB); PG8_STAGE(PG8_SA(0, 0), cA, voffA, rA); PG8_STAGES(0, cS); PG8_STAGE(PG8_SA(0, 1), cA + hstep, voffA, rA);
        if (wr == 1) PG8_BAR;
        PG8_WAIT_V(2); PG8_BAR;
        PG8_STAGE(PG8_SB(1, 0), cB + kstep, voffB, rB); PG8_STAGE(PG8_SA(1, 0), cA + kstep, voffA, rA); PG8_STAGES(1, cS + kstep); PG8_STAGE(PG8_SB(1, 1), cB + hstep + kstep, voffB, rB);
        PG8_WAIT_V(6); PG8_BAR;
    } else {
        PG8_STAGE(PG8_SB(0, 0), cB, voffB, rB); PG8_STAGE(PG8_SA(0, 0), cA, voffA, rA); PG8_STAGE(PG8_SB(0, 1), cB + hstep, voffB, rB); PG8_STAGE(PG8_SA(0, 1), cA + hstep, voffA, rA);
        if (wr == 1) PG8_BAR;
        PG8_WAIT_V(4); PG8_BAR;
        PG8_STAGE(PG8_SB(1, 0), cB + kstep, voffB, rB); PG8_STAGE(PG8_SA(1, 0), cA + kstep, voffA, rA); PG8_STAGE(PG8_SB(1, 1), cB + hstep + kstep, voffB, rB);
        PG8_WAIT_V(6); PG8_BAR;
    }
    for (;;) {
        const bool has_next = S.next(ui + 1, nxt);
        const unsigned nA = has_next ? (unsigned)nxt.pm * tstep : cA, nB = has_next ? (unsigned)nxt.pn * tstep : cB;
        const unsigned nS = has_next ? (unsigned)(MP + 8 * nxt.pm) * LD * 2 : cS;
        for (int t = 0; t < nt; t += 2) {
            const bool last = (t == nt - 2);
            const unsigned a1 = cA + (unsigned)(t + 1) * kstep;
            const unsigned a2 = last ? nA : cA + (unsigned)(t + 2) * kstep, b2 = last ? nB : cB + (unsigned)(t + 2) * kstep;
            const unsigned a3 = a2 + kstep, b3 = b2 + kstep;
            const unsigned s2 = last ? nS : cS + (unsigned)(t + 2) * kstep, s3 = s2 + kstep;
            if (last && has_next) S.a_ready(nxt);
            if constexpr (Epi::STATS_LDS) { if (last) {
                int l_ = lane; asm volatile("" : "+v"(l_));
                const char* sp = (const char*)E.stats + (size_t)cur.pm * (BM * 64) + (size_t)(wid * 2048 + l_ * 16);
#pragma unroll
                for (int _i = 0; _i < 2; ++_i) __builtin_amdgcn_global_load_lds((const unsigned*)(sp + _i * 1024), (PG8_LAS unsigned*)(lds + STAGE_BYTES + wid * 2048 + _i * 1024), 16, 0, 0); } }
            if constexpr (SP2) {
            PG8_LDB(B0, 0, 0); PG8_LDB(B1, 0, 1); PG8_SCHED; PG8_LDA(At, 0, 0); PG8_LDS(0); PG8_STAGE(PG8_SA(1, 1), a1 + hstep, voffA, rA);
            PG8_WAIT_V(8); PG8_WAIT_L(0); PG8_BAR; PG8_MMA(0, 0, At, B0); PG8_MMA(0, 1, At, B1); PG8_MMAS(); PG8_BAR; PG8_SCHED;
            PG8_LDA(At, 0, 1); PG8_STAGE(PG8_SB(0, 0), b2, voffB, rB); PG8_STAGE(PG8_SB(0, 1), b2 + hstep, voffB, rB); PG8_STAGE(PG8_SA(0, 0), a2, voffA, rA); PG8_STAGES(0, s2);
            PG8_WAIT_V(8); PG8_WAIT_L(0); PG8_BAR; PG8_MMA(1, 0, At, B0); PG8_MMA(1, 1, At, B1); PG8_BAR; PG8_SCHED;
            PG8_LDB(B0, 1, 0); PG8_LDB(B1, 1, 1); PG8_SCHED; PG8_LDA(At, 1, 0); PG8_LDS(1); PG8_STAGE(PG8_SA(0, 1), a2 + hstep, voffA, rA);
            PG8_WAIT_V(8); PG8_WAIT_L(0); PG8_BAR; PG8_MMA(0, 0, At, B0); PG8_MMA(0, 1, At, B1); PG8_MMAS(); PG8_BAR; PG8_SCHED;
            PG8_LDA(At, 1, 1); PG8_STAGE(PG8_SB(1, 0), b3, voffB, rB); PG8_STAGE(PG8_SB(1, 1), b3 + hstep, voffB, rB); PG8_STAGE(PG8_SA(1, 0), a3, voffA, rA); PG8_STAGES(1, s3);
            PG8_WAIT_V(8); PG8_WAIT_L(0); PG8_BAR; PG8_MMA(1, 0, At, B0); PG8_MMA(1, 1, At, B1); PG8_BAR; PG8_SCHED;
            } else {
            PG8_LDB(B0, 0, 0); PG8_SCHED; PG8_LDA(At, 0, 0); PG8_STAGE(PG8_SA(1, 1), a1 + hstep, voffA, rA);
            PG8_WAIT_L(8); PG8_BAR; PG8_WAIT_L(0); PG8_MMA(0, 0, At, B0); PG8_BAR; PG8_SCHED;
            PG8_LDB(B1, 0, 1); PG8_STAGE(PG8_SB(0, 0), b2, voffB, rB);
            PG8_BAR; PG8_WAIT_L(0); PG8_MMA(0, 1, At, B1); PG8_BAR;
            PG8_LDA(At, 0, 1); PG8_STAGE(PG8_SA(0, 0), a2, voffA, rA);
            PG8_BAR; PG8_WAIT_L(0); PG8_MMA(1, 0, At, B0); PG8_BAR; PG8_SCHED;
            PG8_STAGE(PG8_SB(0, 1), b2 + hstep, voffB, rB);
            PG8_WAIT_V(6); PG8_BAR; PG8_MMA(1, 1, At, B1); PG8_BAR;
            PG8_LDB(B0, 1, 0); PG8_SCHED; PG8_LDA(At, 1, 0); PG8_STAGE(PG8_SA(0, 1), a2 + hstep, voffA, rA);
            PG8_WAIT_L(8); PG8_BAR; PG8_WAIT_L(0); PG8_MMA(0, 0, At, B0); PG8_BAR; PG8_SCHED;
            PG8_LDB(B1, 1, 1); PG8_STAGE(PG8_SB(1, 0), b3, voffB, rB);
            PG8_BAR; PG8_WAIT_L(0); PG8_MMA(0, 1, At, B1); PG8_BAR;
            PG8_LDA(At, 1, 1); PG8_STAGE(PG8_SA(1, 0), a3, voffA, rA);
            PG8_BAR; PG8_WAIT_L(0); PG8_MMA(1, 0, At, B0); PG8_BAR; PG8_SCHED;
            PG8_STAGE(PG8_SB(1, 1), b3 + hstep, voffB, rB);
            PG8_WAIT_V(6); PG8_BAR; PG8_MMA(1, 1, At, B1); PG8_BAR;
            }
        }
        if constexpr (ALIGN_EPI) { if (wr == 0) PG8_BAR; }
        if constexpr (!Epi::AFTER_DRAIN) { E(acc, cur, wr, wc, fr, fq); if constexpr (Epi::STRIP) { E.strip(accS, cur, wr, wc, fr, fq); accS[0] = (f32x4){0.f, 0.f, 0.f, 0.f}; accS[1] = accS[0]; } S.done(cur); }
        if (!has_next) break;
#pragma unroll
        for (int a = 0; a < 2; ++a)
#pragma unroll
            for (int b = 0; b < 2; ++b)
#pragma unroll
                for (int m = 0; m < 4; ++m)
#pragma unroll
                    for (int n = 0; n < 2; ++n) acc[a][b][m][n] = (f32x4){0.f, 0.f, 0.f, 0.f};
        cur = nxt; cA = nA; cB = nB; cS = nS; ++ui;
        if constexpr (ALIGN_EPI) { if (wr == 1) PG8_BAR; }
    }
    PG8_WAIT_V(0);
    if constexpr (!ALIGN_EPI) { if (wr == 0) PG8_BAR; }
    PG8_BAR;
    if constexpr (Epi::AFTER_DRAIN) { E.fused(acc, cur, wr, wc, fr, fq, lds, wid, lane); S.done(cur); }
#undef PG8_SA
#undef PG8_SB
#undef PG8_STAGE
#undef PG8_STAGES
#undef PG8_LDS
#undef PG8_MMAS
#undef PG8_LDA
#undef PG8_LDB
#undef PG8_MMA
#undef PG8_WAIT_V
#undef PG8_WAIT_L
#undef PG8_BAR
#undef PG8_SCHED
}
}
#define GAS __attribute__((address_space(1)))
#define LAS __attribute__((address_space(3)))
typedef unsigned short bf16;
typedef unsigned v4u __attribute__((ext_vector_type(4)));
typedef float f32x4 __attribute__((ext_vector_type(4)));
typedef short bf16x8 __attribute__((ext_vector_type(8)));
typedef GAS unsigned gu32;
typedef GAS unsigned long long gu64;
#define RLX_AGENT __ATOMIC_RELAXED, __HIP_MEMORY_SCOPE_AGENT
#define LDS_WAIT() asm volatile("s_waitcnt lgkmcnt(0)" ::: "memory")
#define VM_WAIT() asm volatile("s_waitcnt vmcnt(0)" ::: "memory")
__device__ __forceinline__ unsigned long long rt() { return __builtin_amdgcn_s_memrealtime(); }
__device__ __forceinline__ unsigned f2bf(float f) { unsigned u = __builtin_bit_cast(unsigned, f); return (u + 0x7fffu + ((u >> 16) & 1u)) >> 16; }
__device__ __forceinline__ unsigned pk2(float lo, float hi) { return f2bf(lo) | (f2bf(hi) << 16); }

#define XB_TMO      128
#define XB_XCNT(j)  (256  + 64 * (j))
#define XB_XSUB(j)  (1280 + 64 * (j))
#define XB_XGEN(j)  (2304 + 64 * (j))
#define XB_TOP      3328
#define XB_TOPGEN   3392
#define XCD_BAR_WORDS 3456
#define XB_SPIN_CAP (1u << 18)

__device__ __forceinline__ unsigned xb_ld(unsigned* p)              { return __hip_atomic_load(p, __ATOMIC_RELAXED, __HIP_MEMORY_SCOPE_AGENT); }
__device__ __forceinline__ unsigned xb_add(unsigned* p, unsigned v) { return __hip_atomic_fetch_add(p, v, __ATOMIC_RELAXED, __HIP_MEMORY_SCOPE_AGENT); }
__device__ __forceinline__ unsigned xb_xcc_id() { return (unsigned)__builtin_amdgcn_s_getreg((3 << 11) | 20) & 0xFu; }
#define XB_SPIN(cond, bar) do { unsigned _sp = 0; while (cond) { __builtin_amdgcn_s_sleep(1); \
    if ((++_sp & 255u) == 0u) { if (xb_ld(&(bar)[XB_TMO])) break; if (_sp > XB_SPIN_CAP) { atomicAdd(&(bar)[XB_TMO], 1u); break; } } } } while (0)

struct XcdBarrier {
    unsigned* bar; unsigned x;
    volatile LAS unsigned* st;
};

__device__ __forceinline__ XcdBarrier xcd_barrier_post(unsigned* bar, volatile LAS unsigned* st) {
    XcdBarrier b; b.bar = bar; b.x = xb_xcc_id(); b.st = st;
    if (threadIdx.x == 0) (void)xb_add(&bar[XB_XCNT(b.x)], 1u);
    return b;
}
__device__ __forceinline__ void xcd_barrier_complete(unsigned* bar, unsigned x, unsigned& nloc, unsigned& nx) {
    const unsigned G = gridDim.x * gridDim.y * gridDim.z;
    unsigned sum, cnt, mine, sp = 0u;
    for (;;) {
        sum = 0u; cnt = 0u; mine = 0u;
#pragma unroll
        for (unsigned j = 0; j < 16; ++j) { const unsigned c = xb_ld(&bar[XB_XCNT(j)]); sum += c; cnt += (c > 0u) ? 1u : 0u; mine = (j == x) ? c : mine; }
        if (sum == G) break;
        __builtin_amdgcn_s_sleep(1);
        if ((++sp & 255u) == 0u) { if (xb_ld(&bar[XB_TMO])) break; if (sp > XB_SPIN_CAP) { atomicAdd(&bar[XB_TMO], 1u); break; } }
    }
    nloc = mine > 0u ? mine : 1u; nx = cnt > 0u ? cnt : 1u;
}

__device__ __forceinline__ void xcd_barrier(const XcdBarrier& b) {
    asm volatile("s_waitcnt vmcnt(0)" ::: "memory");
    __syncthreads();
    if (threadIdx.x == 0) {
        unsigned* bar = b.bar;
        __builtin_amdgcn_s_waitcnt(0);
        unsigned nloc = b.st[0], nx = b.st[1];
        if (nloc == 0u) { xcd_barrier_complete(bar, b.x, nloc, nx); b.st[0] = nloc; b.st[1] = nx; }
        const unsigned old = xb_add(&bar[XB_XSUB(b.x)], 1u);
        const unsigned gen = old / nloc;
        if (old + 1u == (gen + 1u) * nloc) {
            __builtin_amdgcn_fence(__ATOMIC_RELEASE, "agent");
            asm volatile("s_waitcnt vmcnt(0)" ::: "memory");
            const unsigned og = xb_add(&bar[XB_TOP], 1u);
            const unsigned tg = og / nx;
            if (og + 1u == (tg + 1u) * nx) xb_add(&bar[XB_TOPGEN], 1u);
            asm volatile("buffer_inv sc1" ::: "memory");
            if (og + 1u != (tg + 1u) * nx) XB_SPIN(xb_ld(&bar[XB_TOPGEN]) == tg, bar);
            xb_add(&bar[XB_XGEN(b.x)], 1u);
            asm volatile("s_waitcnt vmcnt(0)" ::: "memory");
        } else {
            asm volatile("buffer_inv sc1" ::: "memory");
            XB_SPIN(xb_ld(&bar[XB_XGEN(b.x)]) == gen, bar);
            asm volatile("s_waitcnt vmcnt(0)" ::: "memory");
        }
    }
    __syncthreads();
}
namespace att {
typedef short bf16x8 __attribute__((ext_vector_type(8)));
typedef short s16x4 __attribute__((ext_vector_type(4)));
typedef float f32x16 __attribute__((ext_vector_type(16)));
typedef float f32x4 __attribute__((ext_vector_type(4)));
typedef unsigned u32x4 __attribute__((ext_vector_type(4)));
typedef unsigned u32x2 __attribute__((ext_vector_type(2)));
typedef unsigned short bf16_t;
#define ATT_LAS __attribute__((address_space(3)))
constexpr int KCH = 4112;
constexpr int VDH = 16384 + 64;
constexpr int BIASW = 192;
constexpr int L_K = 0, L_V = 8 * KCH, L_BIAS = L_V + 2 * VDH, L_END = L_BIAS + 8 * BIASW * 4;
static_assert(L_V % 16 == 0 && L_BIAS % 16 == 0 && L_END <= 131072, "attention LDS map");
__device__ __forceinline__ int crow(int r, int hi) { return (r & 3) + 8 * (r >> 2) + 4 * hi; }
__device__ __forceinline__ unsigned cvtpk(float lo, float hi) { unsigned r; asm volatile("v_cvt_pk_bf16_f32 %0, %1, %2" : "=v"(r) : "v"(lo), "v"(hi)); return r; }
__device__ __forceinline__ s16x4 vtr(const ATT_LAS unsigned char* p) { typedef short v4i16_t __attribute__((ext_vector_type(4))); return __builtin_bit_cast(s16x4, __builtin_amdgcn_ds_read_tr16_b64_v4i16((ATT_LAS v4i16_t*)p)); }

struct Tensors {
    const bf16_t *Q, *Kb, *Vb, *Gb, *Ub, *CK, *CV;
    bf16_t* MIX;
    const float *wconv, *sconv, *sinks, *relb;
};

template <bool FULL>
__device__ __forceinline__ void wave_unit(const Tensors& T, ATT_LAS unsigned char* lds, const bf16x8 (&qf)[4], int g, int head, int ql, int r32, int hi, int lane, bool do_store, size_t orow) {
    f32x16 s[5];
    const ATT_LAS unsigned char* kbase = lds + L_K + hi * KCH + (32 * g + r32) * 16;
#pragma unroll
    for (int t = 0; t < 5; ++t) {
        s[t] = (f32x16){0.f, 0.f, 0.f, 0.f, 0.f, 0.f, 0.f, 0.f, 0.f, 0.f, 0.f, 0.f, 0.f, 0.f, 0.f, 0.f};
#pragma unroll
        for (int ks = 0; ks < 4; ++ks) { const bf16x8 kf = *(const ATT_LAS bf16x8*)(kbase + 2 * ks * KCH + t * 512); s[t] = __builtin_amdgcn_mfma_f32_32x32x16_bf16(kf, qf[ks], s[t], 0, 0, 0); }
    }
    const ATT_LAS float* bt = (const ATT_LAS float*)(lds + L_BIAS) + head * BIASW + (ql - 4 * hi);
    const float sink2 = T.sinks[head] * LOG2E;
    const int qc = ql - 4 * hi;
    float mx = -1e30f;
#pragma unroll
    for (int t = 0; t < 5; ++t)
#pragma unroll
        for (int r = 0; r < 16; ++r) {
            const int c0 = (r & 3) + 8 * (r >> 2);
            float v = s[t][r] + bt[160 - 32 * t - c0];
            if (t == 0) v = (c0 > qc) ? v : -1e30f;
            if (t == 4) v = (c0 <= qc) ? v : -1e30f;
            if (!FULL) { if (32 * g + 32 * t + 31 < 128) v = -1e30f; else if (32 * g + 32 * t < 128) v = (32 * g + 32 * t + c0 + 4 * hi >= 128) ? v : -1e30f; }
            s[t][r] = v; mx = fmaxf(mx, v);
        }
    mx = fmaxf(mx, __shfl_xor(mx, 32)); mx = fmaxf(mx, sink2);
    float sum = 0.f;
#pragma unroll
    for (int t = 0; t < 5; ++t)
#pragma unroll
        for (int r = 0; r < 16; ++r) { const float p = __builtin_amdgcn_exp2f(s[t][r] - mx); s[t][r] = p; sum += p; }
    sum += __shfl_xor(sum, 32); sum += __builtin_amdgcn_exp2f(sink2 - mx);
    const float rl = __builtin_amdgcn_rcpf(sum);
    f32x16 o[2];
    o[0] = (f32x16){0.f, 0.f, 0.f, 0.f, 0.f, 0.f, 0.f, 0.f, 0.f, 0.f, 0.f, 0.f, 0.f, 0.f, 0.f, 0.f}; o[1] = o[0];
    const ATT_LAS unsigned char* vbase = lds + L_V + (32 * g + 4 * hi + ((lane & 15) >> 2)) * 64 + ((lane >> 4) & 1) * 32 + (lane & 3) * 8;
#pragma unroll
    for (int t = 0; t < 5; ++t)
#pragma unroll
        for (int ks = 0; ks < 2; ++ks) {
            u32x4 pw; pw.x = cvtpk(s[t][8 * ks + 0], s[t][8 * ks + 1]); pw.y = cvtpk(s[t][8 * ks + 2], s[t][8 * ks + 3]); pw.z = cvtpk(s[t][8 * ks + 4], s[t][8 * ks + 5]); pw.w = cvtpk(s[t][8 * ks + 6], s[t][8 * ks + 7]);
            const bf16x8 pf = __builtin_bit_cast(bf16x8, pw);
#pragma unroll
            for (int dt = 0; dt < 2; ++dt) {
                const ATT_LAS unsigned char* vp = vbase + dt * VDH + (32 * t + 16 * ks) * 64;
                const s16x4 lo = vtr(vp), hh = vtr(vp + 512);
                const bf16x8 vf = (bf16x8){lo[0], lo[1], lo[2], lo[3], hh[0], hh[1], hh[2], hh[3]};
                o[dt] = __builtin_amdgcn_mfma_f32_32x32x16_bf16(vf, pf, o[dt], 0, 0, 0);
            }
        }
    if (do_store) {
        bf16_t* Op = T.MIX + orow * 1024 + head * 64 + 4 * hi;
#pragma unroll
        for (int dt = 0; dt < 2; ++dt)
#pragma unroll
            for (int i = 0; i < 4; ++i) { u32x2 w; w.x = cvtpk(o[dt][4 * i] * rl, o[dt][4 * i + 1] * rl); w.y = cvtpk(o[dt][4 * i + 2] * rl, o[dt][4 * i + 3] * rl);
                *(u32x2*)(Op + 32 * dt + 8 * i) = w; }
    }
}

__device__ __forceinline__ void unit(const Tensors& T, ATT_LAS unsigned char* lds, bool sample, int blk, int kvh) {
    const int tid = threadIdx.x, lane = tid & 63, wid = __builtin_amdgcn_readfirstlane(tid >> 6), r32 = lane & 31, hi = lane >> 5;
    const int R0 = sample ? (MP + blk * 4) : blk * 128;
    const bool prev_valid = sample ? true : ((blk & 63) != 0);
    const int curN = sample ? 4 : 128;
    const bf16_t* prevK = sample ? T.CK + (size_t)blk * 128 * 128 : T.Kb + (size_t)(R0 - 128) * 128;
    const bf16_t* prevV = sample ? T.CV + (size_t)blk * 128 * 128 : T.Vb + (size_t)(R0 - 128) * 128;
    const bf16_t* curK = T.Kb + (size_t)R0 * 128; const bf16_t* curV = T.Vb + (size_t)R0 * 128;
    u32x4 kv[4], vv[4];
#pragma unroll
    for (int i = 0; i < 4; ++i) {
        const int c = tid + 512 * i, key = c >> 3, ch = c & 7;
        kv[i] = (u32x4){0u, 0u, 0u, 0u}; vv[i] = (u32x4){0u, 0u, 0u, 0u};
        if (key < 128) { if (prev_valid) { kv[i] = *(const u32x4*)(prevK + (size_t)key * 128 + kvh * 64 + ch * 8); vv[i] = *(const u32x4*)(prevV + (size_t)key * 128 + kvh * 64 + ch * 8); } }
        else { int kr = key - 128; kr = kr < curN ? kr : curN - 1; kv[i] = *(const u32x4*)(curK + (size_t)kr * 128 + kvh * 64 + ch * 8); vv[i] = *(const u32x4*)(curV + (size_t)kr * 128 + kvh * 64 + ch * 8); }
    }
    const int nwu = sample ? 4 : 16;
    const int ql = sample ? (r32 < 4 ? r32 : 3) : r32;
    bf16x8 qf[4], qn[4];
    { const int wu = wid < nwu ? wid : 0, hq = wu & 3, g = sample ? 0 : (wu >> 2);
      const bf16_t* Qp = T.Q + (size_t)(R0 + 32 * g + ql) * 512 + (kvh * 4 + hq) * 64 + hi * 8;
#pragma unroll
      for (int ks = 0; ks < 4; ++ks) qf[ks] = *(const bf16x8*)(Qp + ks * 16); }
    {
        const int cc = tid & 31, c0 = 256 * kvh + 8 * cc, rg = tid >> 5;
        float w0[8], w1[8], w2[8];
#pragma unroll
        for (int e = 0; e < 8; ++e) { w0[e] = T.wconv[c0 + e]; w1[e] = T.wconv[512 + c0 + e]; w2[e] = T.wconv[1024 + c0 + e]; }
#define ldu(row, u) do { const u32x4 w_ = *(const u32x4*)(T.Ub + (size_t)(row) * 512 + c0); \
            u[0] = bf_lo(w_.x); u[1] = bf_hi(w_.x); u[2] = bf_lo(w_.y); u[3] = bf_hi(w_.y); u[4] = bf_lo(w_.z); u[5] = bf_hi(w_.z); u[6] = bf_lo(w_.w); u[7] = bf_hi(w_.w); } while (0)
        if (!sample) {
            const int ra = R0 + 8 * rg;
            const bool seq_start = ((blk & 63) == 0) && (rg == 0);
            u32x4 uw[10], gw[8];
#pragma unroll
            for (int j = 0; j < 10; ++j) uw[j] = (j < 2 && seq_start) ? (u32x4){0u, 0u, 0u, 0u} : *(const u32x4*)(T.Ub + (size_t)(ra - 2 + j) * 512 + c0);
#pragma unroll
            for (int j = 0; j < 8; ++j) gw[j] = *(const u32x4*)(T.Gb + (size_t)(ra + j) * 512 + c0);
#pragma unroll
            for (int j = 0; j < 8; ++j) {
                const float um2[8] = {bf_lo(uw[j].x), bf_hi(uw[j].x), bf_lo(uw[j].y), bf_hi(uw[j].y), bf_lo(uw[j].z), bf_hi(uw[j].z), bf_lo(uw[j].w), bf_hi(uw[j].w)};
                const float um1[8] = {bf_lo(uw[j + 1].x), bf_hi(uw[j + 1].x), bf_lo(uw[j + 1].y), bf_hi(uw[j + 1].y), bf_lo(uw[j + 1].z), bf_hi(uw[j + 1].z), bf_lo(uw[j + 1].w), bf_hi(uw[j + 1].w)};
                const float u0[8] = {bf_lo(uw[j + 2].x), bf_hi(uw[j + 2].x), bf_lo(uw[j + 2].y), bf_hi(uw[j + 2].y), bf_lo(uw[j + 2].z), bf_hi(uw[j + 2].z), bf_lo(uw[j + 2].w), bf_hi(uw[j + 2].w)};
                const float gb[8] = {bf_lo(gw[j].x), bf_hi(gw[j].x), bf_lo(gw[j].y), bf_hi(gw[j].y), bf_lo(gw[j].z), bf_hi(gw[j].z), bf_lo(gw[j].w), bf_hi(gw[j].w)};
                float y[8];
#pragma unroll
                for (int e = 0; e < 8; ++e) y[e] = gb[e] * (w0[e] * um2[e] + w1[e] * um1[e] + w2[e] * u0[e]);
                u32x4 w; w.x = cvtpk(y[0], y[1]); w.y = cvtpk(y[2], y[3]); w.z = cvtpk(y[4], y[5]); w.w = cvtpk(y[6], y[7]);
                *(u32x4*)(T.MIX + (size_t)(ra + j) * 1024 + 512 + c0) = w;
            }
        } else if (rg < 4) {
            const int row = R0 + rg;
            float ua[3][8];
#pragma unroll
            for (int k = 0; k < 3; ++k) { const int ss = rg - 2 + k;
                if (ss >= 0) ldu(R0 + ss, ua[k]);
                else { const float* sp = T.sconv + (size_t)(blk * 2 + (ss + 2)) * 512 + c0;
#pragma unroll
                    for (int e = 0; e < 8; ++e) ua[k][e] = sp[e]; } }
            const u32x4 gw = *(const u32x4*)(T.Gb + (size_t)row * 512 + c0);
            const float gb[8] = {bf_lo(gw.x), bf_hi(gw.x), bf_lo(gw.y), bf_hi(gw.y), bf_lo(gw.z), bf_hi(gw.z), bf_lo(gw.w), bf_hi(gw.w)};
            float y[8];
#pragma unroll
            for (int e = 0; e < 8; ++e) y[e] = gb[e] * (w0[e] * ua[0][e] + w1[e] * ua[1][e] + w2[e] * ua[2][e]);
            u32x4 w; w.x = cvtpk(y[0], y[1]); w.y = cvtpk(y[2], y[3]); w.z = cvtpk(y[4], y[5]); w.w = cvtpk(y[6], y[7]);
            *(u32x4*)(T.MIX + (size_t)row * 1024 + 512 + c0) = w;
        }
    }
#undef ldu
#pragma unroll
    for (int i = 0; i < 4; ++i) {
        const int c = tid + 512 * i, key = c >> 3, ch = c & 7;
        *(ATT_LAS u32x4*)(lds + L_K + ch * KCH + key * 16) = kv[i];
        *(ATT_LAS u32x4*)(lds + L_V + (ch >> 2) * VDH + key * 64 + (ch & 3) * 16) = vv[i];
    }
    __syncthreads();
    for (int wu = wid; wu < nwu; wu += 8) {
        const int hq = wu & 3, g = sample ? 0 : (wu >> 2), head = kvh * 4 + hq;
        if (wu + 8 < nwu) { const int g2 = (wu + 8) >> 2; const bf16_t* Qp = T.Q + (size_t)(R0 + 32 * g2 + ql) * 512 + head * 64 + hi * 8;
#pragma unroll
            for (int ks = 0; ks < 4; ++ks) qn[ks] = *(const bf16x8*)(Qp + ks * 16); }
        const bool do_store = !sample || r32 < 4; const size_t orow = (size_t)(R0 + 32 * g + ql);
        if (prev_valid) wave_unit<true>(T, lds, qf, g, head, ql, r32, hi, lane, do_store, orow);
        else            wave_unit<false>(T, lds, qf, g, head, ql, r32, hi, lane, do_store, orow);
#pragma unroll
        for (int ks = 0; ks < 4; ++ks) qf[ks] = qn[ks];
    }
    __syncthreads();
}
}

constexpr int NWAVES = 8;
#ifndef MK_N_LAUNCHES
#define MK_N_LAUNCHES 1
#endif
constexpr int NPHASE = 9;
constexpr int N_LAUNCHES = MK_N_LAUNCHES;
static_assert(N_LAUNCHES == 1 || N_LAUNCHES == NPHASE, "MK_N_LAUNCHES is 1 or 9");

constexpr size_t MiB = 1u << 20;
constexpr size_t WS_CTL = 0, CTL_ZERO_BYTES = 64 * 1024;
constexpr size_t WS_W1GU = 2 * MiB, WS_W1D = 13 * MiB, WS_WIN = 19 * MiB, WS_WOUT = 24 * MiB, WS_W2GU = 26 * MiB, WS_W2D = 37 * MiB, WS_WPG = 43 * MiB, WS_WPP = 45 * MiB;
constexpr size_t STATS_BYTES = (size_t)M * 16 * 4;
constexpr size_t WS_STATS = 46 * MiB;
constexpr size_t WS_RS0 = WS_STATS + 3 * STATS_BYTES;
constexpr size_t WS_CK = 50 * MiB, WS_CV = 54 * MiB;
constexpr size_t WS_PEB = 58 * MiB;
constexpr size_t WS_XB = 67 * MiB;
constexpr size_t WS_KB = 100 * MiB, WS_VB = 105 * MiB;
constexpr size_t WS_PP = 110 * MiB;
constexpr size_t WS_ACT = 143 * MiB;
constexpr size_t WS_QB = 143 * MiB, WS_GB = WS_QB + (size_t)M * 512 * 2, WS_UB = WS_GB + (size_t)M * 512 * 2, WS_MIX = WS_UB + (size_t)M * 512 * 2;
constexpr size_t WS_END = 236 * MiB;
static_assert(WS_W1GU + (size_t)2 * FF * D * 2 <= WS_W1D && WS_W1D + (size_t)D * FFP * 2 <= WS_WIN && WS_WIN + (size_t)NIN * D * 2 <= WS_WOUT && WS_WOUT + (size_t)D * D * 2 <= WS_W2GU
              && WS_W2GU + (size_t)2 * FF * D * 2 <= WS_W2D && WS_W2D + (size_t)D * FFP * 2 <= WS_WPG && WS_WPG + (size_t)D * D * 2 <= WS_WPP && WS_WPP + (size_t)D * DPLE * 2 <= WS_STATS
              && WS_RS0 + (size_t)M * 4 <= WS_CK && WS_PEB + (size_t)M * DPLE * 2 <= WS_XB && WS_XB + (size_t)M * D * 2 <= WS_KB && WS_KB + (size_t)M * 128 * 2 <= WS_VB
              && WS_VB + (size_t)M * 128 * 2 <= WS_PP && WS_PP + (size_t)M * D * 2 <= WS_ACT && WS_ACT + (size_t)M * FFP * 2 <= WS_END && WS_MIX + (size_t)M * D * 2 <= WS_END, "d_ws map");
constexpr int CW_BAR = 4096;
constexpr size_t O_Y = 0, O_KWP = (size_t)M * D, O_VWP = O_KWP + 2 * 128 * 128, O_CVP = O_VWP + 2 * 128 * 128, O_KWS = O_CVP + 2 * 2 * 512, O_VWS = O_KWS + (size_t)128 * 128 * 128,
                 O_CVS = O_VWS + (size_t)128 * 128 * 128, O_END = O_CVS + 128 * 2 * 512;
constexpr int RING_OFF = 0, RING_BYTES = 131072;
constexpr int STAB_OFF = RING_BYTES, STAB_BYTES = 16384;
constexpr int STRIP_BYTES = 4096;
constexpr int LDSCTL_OFF = STAB_OFF + STAB_BYTES + STRIP_BYTES, MISC_OFF = LDSCTL_OFF + 320;
constexpr int LDS_BYTES = 153600;
static_assert(MISC_OFF + 128 <= LDS_BYTES, "LDS map");

struct Args { const float* in[26]; float* out; unsigned char* ws; int ph_lo, ph_hi, li, pad; };
typedef const __attribute__((address_space(4))) Args* KArgs;
__device__ __forceinline__ KArgs kargs() { KArgs p = (KArgs)__builtin_amdgcn_kernarg_segment_ptr(); asm volatile("" : "+s"(p)); return p; }
struct Frame {
    LAS unsigned char* lds;
    volatile LAS unsigned* MISC;
    gu32* ctl;
    int wave;
    int vcu, G;
};

__device__ __forceinline__ float wave_sum(float v) {
#pragma unroll
    for (int o = 1; o < 64; o <<= 1) v += __shfl_xor(v, o);
    return v;
}
__device__ __forceinline__ int map_swiglu(int n0, int up) { return 256 * (n0 >> 7) + 128 * up + (n0 & 127); }
__device__ __forceinline__ int map_in(int c0) {
    if (c0 < 512) { const int head = c0 >> 6, bj = (c0 >> 5) & 1; return 256 * (head >> 2) + 128 * bj + 32 * (head & 3); }
    if (c0 < 768) { const int t = c0 - 512, hv = t >> 6, bj = (t >> 5) & 1; return 512 + 128 * bj + 32 * hv; }
    if (c0 < 1280) return c0;
    if (c0 < 1792) { const int f = c0 - 1280; return 256 * (5 + (f >> 7)) + (f & 127); }
    { const int f = c0 - 1792; return 256 * (5 + (f >> 7)) + 128 + (f & 127); }
}
__device__ __forceinline__ int map_dst(int mode, int c0) { return mode == 0 ? c0 : mode == 1 ? map_swiglu(c0, 0) : mode == 2 ? map_swiglu(c0, 1) : map_in(c0); }
__device__ __forceinline__ void p0_transpose_item(const float* W, int N, const float* gain, bf16* WT, int KT, int mode, LAS unsigned* T, int k0, int n0, int lane) {
    const int a = lane & 15, b = lane >> 4;
    const float* src = W + (size_t)(k0 + 2 * b) * N + n0 + 4 * a;
    f32x4 va[8], vb[8];
#pragma unroll
    for (int j = 0; j < 8; ++j) { va[j] = *(const GAS f32x4*)(src + (size_t)(8 * j) * N); vb[j] = *(const GAS f32x4*)(src + (size_t)(8 * j + 1) * N); }
    const float wsc = mode == 1 ? LOG2E : mode == 2 ? (1.0f / LOG2E) : 1.0f;
#pragma unroll
    for (int j = 0; j < 8; ++j) { float ga = wsc, gb = wsc; if (gain) { ga = gain[k0 + 8 * j + 2 * b] * wsc; gb = gain[k0 + 8 * j + 2 * b + 1] * wsc; }
#pragma unroll
        for (int e = 0; e < 4; ++e) T[(4 * a + e) * 33 + 4 * j + b] = pk2(va[j][e] * ga, vb[j][e] * gb); }
    LDS_WAIT(); asm volatile("" ::: "memory");
#pragma unroll
    for (int jj = 0; jj < 8; ++jj) { const int n = 8 * jj + (lane >> 3), kc = lane & 7; const LAS unsigned* s = T + n * 33 + 4 * kc;
        v4u o; o.x = s[0]; o.y = s[1]; o.z = s[2]; o.w = s[3];
        const int drow = map_dst(mode, n0 + (n & 32)) + (n & 31);
        *(GAS v4u*)(WT + (size_t)drow * KT + k0 + 8 * kc) = o; }
    LDS_WAIT(); asm volatile("" ::: "memory");
}
__device__ __forceinline__ void p0_weights(Frame& F, KArgs Ap, int which, int gw, int NGW) {
    int tid_ = threadIdx.x; asm volatile("" : "+v"(tid_)); const int lane = tid_ & 63;
    unsigned char* ws = Ap->ws;
    LAS unsigned* scr = (LAS unsigned*)(F.lds + RING_OFF + F.wave * 16384);
    constexpr int I_GU = (D / 64) * (FF / 64), I_DN = (FF / 64) * (D / 64), I_IN = (D / 64) * (NIN / 64), I_SQ = (D / 64) * (D / 64), I_PP = (DPLE / 64) * (D / 64);
    constexpr int NITEMS = 4 * I_GU + 2 * I_DN + I_IN + 2 * I_SQ + I_PP;
    constexpr int B1 = 2 * I_GU, B3 = B1 + I_DN + I_IN + I_SQ + 2 * I_GU, B4 = B3 + I_DN + I_SQ;
    const int lo_ = which == 1 ? B1 : B3, n_ = which == 0 ? B1 + I_PP : which == 1 ? B3 - B1 : B4 - B3;
    for (int it0 = gw; it0 < n_; it0 += NGW) {
        int r = which == 0 ? (it0 < B1 ? it0 : it0 - B1 + B4) : lo_ + it0;
        const float* W; const float* gain = nullptr; bf16* WT; int K, N, mode;
        if (r < I_GU) { W = Ap->in[9]; WT = (bf16*)(ws + WS_W1GU); K = D; N = FF; mode = 1; }
        else if ((r -= I_GU) < I_GU) { W = Ap->in[10]; WT = (bf16*)(ws + WS_W1GU); K = D; N = FF; mode = 2; }
        else if ((r -= I_GU) < I_DN) { W = Ap->in[11]; WT = (bf16*)(ws + WS_W1D); K = FF; N = D; mode = 0; }
        else if ((r -= I_DN) < I_IN) { W = Ap->in[13]; gain = Ap->in[12]; WT = (bf16*)(ws + WS_WIN); K = D; N = NIN; mode = 3; }
        else if ((r -= I_IN) < I_SQ) { W = Ap->in[18]; WT = (bf16*)(ws + WS_WOUT); K = D; N = D; mode = 0; }
        else if ((r -= I_SQ) < I_GU) { W = Ap->in[20]; gain = Ap->in[19]; WT = (bf16*)(ws + WS_W2GU); K = D; N = FF; mode = 1; }
        else if ((r -= I_GU) < I_GU) { W = Ap->in[21]; gain = Ap->in[19]; WT = (bf16*)(ws + WS_W2GU); K = D; N = FF; mode = 2; }
        else if ((r -= I_GU) < I_DN) { W = Ap->in[22]; WT = (bf16*)(ws + WS_W2D); K = FF; N = D; mode = 0; }
        else if ((r -= I_DN) < I_SQ) { W = Ap->in[24]; gain = Ap->in[23]; WT = (bf16*)(ws + WS_WPG); K = D; N = D; mode = 0; }
        else { r -= I_SQ; W = Ap->in[25]; WT = (bf16*)(ws + WS_WPP); K = DPLE; N = D; mode = 0; }
        const int nblk = N / 64, kb = r / nblk, nb = r % nblk, k0 = 64 * kb, n0 = 64 * nb;
        p0_transpose_item(W, N, gain, WT, K == FF ? FFP : K, mode, scr, k0, n0, lane);
    }
}
__device__ __forceinline__ void p0_prologue(Frame& F, KArgs Ap) {
    const int tid0 = (int)threadIdx.x, lane0 = tid0 & 63;
    unsigned char* ws = Ap->ws;
    const int gw = F.vcu * NWAVES + F.wave, NGW = F.G * NWAVES;
    p0_weights(F, Ap, 0, gw, NGW);
    {
        const float* g1 = Ap->in[8]; bf16* XB = (bf16*)(ws + WS_XB);
        f32x4 gv[4];
#pragma unroll
        for (int j = 0; j < 4; ++j) gv[j] = ((const GAS f32x4*)g1)[64 * j + lane0];
        for (int m0 = gw; m0 < M; m0 += 2 * NGW) {
            f32x4 v[2][4];
#pragma unroll
            for (int q = 0; q < 2; ++q) { const int m = m0 + q * NGW; if (m < M) { const float* xrow = (m < MP) ? Ap->in[0] + (size_t)m * D : Ap->in[1] + (size_t)(m - MP) * D;
                const GAS f32x4* xr = (const GAS f32x4*)xrow + lane0;
#pragma unroll
                for (int j = 0; j < 4; ++j) v[q][j] = xr[64 * j]; } }
#pragma unroll
            for (int q = 0; q < 2; ++q) { const int m = m0 + q * NGW; if (m < M) { float s = 0.f;
#pragma unroll
                for (int j = 0; j < 4; ++j) s += (v[q][j].x * v[q][j].x + v[q][j].y * v[q][j].y) + (v[q][j].z * v[q][j].z + v[q][j].w * v[q][j].w);
                const float rms = sqrtf(wave_sum(s) * (1.f / D) + RMS_EPS), rstd = 1.f / rms;
                if (lane0 == 0) ((float*)(ws + WS_RS0))[m] = rms;
                GAS unsigned long long* o8 = (GAS unsigned long long*)(XB + (size_t)m * D) + lane0;
#pragma unroll
                for (int j = 0; j < 4; ++j) { const f32x4 o = v[q][j] * rstd * gv[j]; o8[64 * j] = (unsigned long long)pk2(o.x, o.y) | ((unsigned long long)pk2(o.z, o.w) << 32); } } }
        }
    }
    {
        const int gt = F.vcu * (NWAVES * 64) + tid0, NT = F.G * NWAVES * 64;
        for (int i = gt; i < 3 * MS * 16; i += NT) { const int k = i / (MS * 16), j = i - k * (MS * 16); ((float*)(ws + WS_STATS + (size_t)k * STATS_BYTES))[(size_t)MP * 16 + j] = 0.f; }
        bf16* PEB = (bf16*)(ws + WS_PEB);
        constexpr int NPE = M * DPLE / 8, NPEP = MP * DPLE / 8;
        for (int i = gt; i < NPE; i += NT) {
            const float* src = (i < NPEP) ? Ap->in[2] + (size_t)i * 8 : Ap->in[3] + (size_t)(i - NPEP) * 8;
            const f32x4 a = *(const GAS f32x4*)src, b = *(const GAS f32x4*)(src + 4);
            v4u o; o.x = pk2(a.x, a.y); o.y = pk2(a.z, a.w); o.z = pk2(b.x, b.y); o.w = pk2(b.z, b.w);
            *(GAS v4u*)(PEB + (size_t)i * 8) = o;
        }
        constexpr int NC = 128 * 128 * 128 / 8;
        for (int i = gt; i < 2 * NC; i += NT) {
            const int which = i >= NC, j = which ? i - NC : i;
            const float* src = Ap->in[4 + which] + (size_t)j * 8;
            const f32x4 a = *(const GAS f32x4*)src, b = *(const GAS f32x4*)(src + 4);
            v4u o; o.x = pk2(a.x, a.y); o.y = pk2(a.z, a.w); o.z = pk2(b.x, b.y); o.w = pk2(b.z, b.w);
            *(GAS v4u*)((bf16*)(ws + (which ? WS_CV : WS_CK)) + (size_t)j * 8) = o;
            const int w = (j >> 4) & 127;
            if (w >= 4) { float* dst = Ap->out + (which ? O_VWS : O_KWS) + (size_t)j * 8 - 512; *(GAS f32x4*)dst = a; *(GAS f32x4*)(dst + 4) = b; }
        }
    }
}

__constant__ unsigned char c_bucket[128] = {0, 1, 2, 3, 4, 5, 6, 7, 8, 9, 10, 11, 12, 13, 14, 15, 16, 16, 16, 17, 17, 18, 18, 18, 19, 19, 19, 20, 20, 20, 20, 21, 21, 21, 21, 22, 22, 22, 22, 22, 23, 23, 23, 23, 23, 23, 24, 24, 24, 24, 24, 24,
    25, 25, 25, 25, 25, 25, 25, 26, 26, 26, 26, 26, 26, 26, 26, 27, 27, 27, 27, 27, 27, 27, 27, 27, 27, 28, 28, 28, 28, 28, 28, 28, 28, 28, 28, 29, 29, 29, 29, 29, 29, 29, 29, 29, 29, 29, 29, 30, 30, 30, 30, 30, 30, 30, 30, 30, 30, 30, 30, 30, 30,
    31, 31, 31, 31, 31, 31, 31, 31, 31, 31, 31, 31, 31, 31, 31};

__global__ void __launch_bounds__(NWAVES * 64, 2) mk_fwd(Args args) {
    extern __shared__ __attribute__((aligned(16))) unsigned char lds[];
    Frame F;
    F.lds = (LAS unsigned char*)lds;
    F.MISC = (volatile LAS unsigned*)(F.lds + MISC_OFF);
    F.wave = __builtin_amdgcn_readfirstlane((int)threadIdx.x >> 6);
    F.G = gridDim.x; { const int bx = blockIdx.x; F.vcu = (F.G % 8 == 0) ? (bx % 8) * (F.G / 8) + bx / 8 : bx; }
    F.ctl = (gu32*)(args.ws + WS_CTL);
    for (int u = (int)threadIdx.x; u < (LDS_BYTES - LDSCTL_OFF) / 4; u += NWAVES * 64) ((LAS unsigned*)(F.lds + LDSCTL_OFF))[u] = 0u;
    __syncthreads();
    XcdBarrier bar; bar.bar = (unsigned*)(F.ctl + CW_BAR); bar.x = 0; bar.st = nullptr;
    if (N_LAUNCHES == 1) bar = xcd_barrier_post((unsigned*)(F.ctl + CW_BAR), F.MISC + 8);
#define GRID_BAR() do { if (N_LAUNCHES == 1) xcd_barrier(bar); } while (0)
    const int lo = args.ph_lo, hi = args.ph_hi;
#define IN(k) (lo <= (k) && (k) < hi)
#define BOTH(k) (IN(k) && IN((k) + 1))
#define PHASE_ARGS() KArgs KA = kargs(); unsigned char* const ws = KA->ws; float* const out = KA->out; (void)out; \
    bf16* const XB = (bf16*)(ws + WS_XB); bf16* const ACT = (bf16*)(ws + WS_ACT); bf16* const PP = (bf16*)(ws + WS_PP); (void)XB; (void)ACT; (void)PP; \
    float* const ST1 = (float*)(ws + WS_STATS); float* const ST2 = (float*)(ws + WS_STATS + STATS_BYTES); float* const ST3 = (float*)(ws + WS_STATS + 2 * STATS_BYTES); (void)ST1; (void)ST2; (void)ST3

    if (IN(0)) { p0_prologue(F, kargs()); if (BOTH(0)) GRID_BAR(); }

    if (IN(1)) { PHASE_ARGS();
        { pg8::Gemm g{XB, (const bf16*)(ws + WS_W1GU), M, 2 * FF, D, D}; pg8::StaticOrder S; S.init(M, 2 * FF, F.G, (int)blockIdx.x);
          pg8::EpiSwiglu<false> E{ACT, nullptr, nullptr};
          pg8::gemm_phase<pg8::EpiSwiglu<false>, pg8::StaticOrder, true, true>(F.lds + RING_OFF, g, S, E); }
        { constexpr int NU = (M / 256) * (2 * FF / 256), FIRST_IDLE = NU % 256;
          if (F.G == 256 && (int)blockIdx.x >= FIRST_IDLE) p0_weights(F, KA, 1, ((int)blockIdx.x - FIRST_IDLE) * NWAVES + F.wave, (256 - FIRST_IDLE) * NWAVES);
          else if (F.G != 256) p0_weights(F, KA, 1, F.vcu * NWAVES + F.wave, F.G * NWAVES); }
        if (BOTH(1)) GRID_BAR();
    }
    if (IN(2)) { PHASE_ARGS();
        pg8::Gemm g{ACT, (const bf16*)(ws + WS_W1D), MP, D, FF, FFP}; pg8::StaticOrder S; S.init(MP, D, F.G, (int)blockIdx.x);
        pg8::EpiResid<true> E{(const float*)(ws + WS_RS0), KA->in[8], XB, ST1, 0.5f};
        pg8::gemm_phase<pg8::EpiResid<true>, pg8::StaticOrder, true, true>(F.lds + RING_OFF, g, S, E);
        if (BOTH(2)) GRID_BAR();
    }
    if (IN(3)) { PHASE_ARGS();
        { pg8::Gemm g{XB, (const bf16*)(ws + WS_WIN), M, NIN, D, D}; pg8::StaticOrder S; S.init(M, NIN, F.G, (int)blockIdx.x);
        pg8::EpiIn E{ST1, F.lds + STAB_OFF, KA->in[14], KA->in[15], (bf16*)(ws + WS_QB), (bf16*)(ws + WS_KB), (bf16*)(ws + WS_VB), (bf16*)(ws + WS_GB), (bf16*)(ws + WS_UB),
                     out + O_KWP, out + O_VWP, out + O_CVP, out + O_KWS, out + O_VWS, out + O_CVS};
        pg8::gemm_phase<pg8::EpiIn, pg8::StaticOrder, true, true>(F.lds + RING_OFF, g, S, E); }
        { int kpp = DPLE; asm volatile("" : "+s"(kpp));
          pg8::Gemm g{(const bf16*)(ws + WS_PEB), (const bf16*)(ws + WS_WPP), M, D, kpp, kpp}; pg8::StaticOrder S; if (F.G == 256) { const int j = (int)blockIdx.x - 82; S.init(M, D, 174, j >= 0 ? j : (1 << 20)); } else S.init(M, D, F.G, (int)blockIdx.x);
          pg8::EpiStoreBf16 E{PP, D};
          pg8::gemm_phase<pg8::EpiStoreBf16, pg8::StaticOrder, true, true>(F.lds + RING_OFF, g, S, E); }
        if (BOTH(3)) GRID_BAR();
    }
    if (IN(4)) { PHASE_ARGS();
        { LAS float* bt = (LAS float*)(F.lds + att::L_BIAS); const float* relb = KA->in[7];
          for (int i = (int)threadIdx.x; i < 8 * att::BIASW; i += NWAVES * 64) { const int h = i / att::BIASW, d = i - h * att::BIASW - 32; bt[i] = (d >= 0 && d < 128) ? relb[c_bucket[d] * 8 + h] * LOG2E : 0.f; } }
        const att::Tensors T{(const bf16*)(ws + WS_QB), (const bf16*)(ws + WS_KB), (const bf16*)(ws + WS_VB), (const bf16*)(ws + WS_GB), (const bf16*)(ws + WS_UB), (const bf16*)(ws + WS_CK), (const bf16*)(ws + WS_CV),
                             (bf16*)(ws + WS_MIX), KA->in[17], KA->in[6], KA->in[16], KA->in[7]};
        for (int i = blockIdx.x; i < 512; i += F.G) { const bool sample = i >= 256; const int j = i & 255; att::unit(T, F.lds, sample, j >> 1, j & 1); }
        if (BOTH(4)) GRID_BAR();
    }
    if (IN(5)) { PHASE_ARGS();
        pg8::Gemm g{(const bf16*)(ws + WS_MIX), (const bf16*)(ws + WS_WOUT), MP, D, D, D}; pg8::StaticOrder S; S.init(MP, D, F.G, (int)blockIdx.x);
        pg8::EpiResid<false> E{nullptr, nullptr, XB, ST2, 1.0f};
        pg8::gemm_phase<pg8::EpiResid<false>, pg8::StaticOrder, true, true>(F.lds + RING_OFF, g, S, E);
        if (BOTH(5)) GRID_BAR();
    }
    if (IN(6)) { PHASE_ARGS();
        pg8::Gemm g{XB, (const bf16*)(ws + WS_W2GU), M, 2 * FF, D, D}; pg8::StaticOrder S; S.init(M, 2 * FF, F.G, (int)blockIdx.x);
        pg8::EpiSwiglu<true> E{ACT, ST2, F.lds + STAB_OFF};
        pg8::gemm_phase<pg8::EpiSwiglu<true>, pg8::StaticOrder, true, true>(F.lds + RING_OFF, g, S, E);
        if (F.G == 256 && (int)blockIdx.x >= 172) p0_weights(F, KA, 2, ((int)blockIdx.x - 172) * NWAVES + F.wave, 84 * NWAVES);
        else if (F.G != 256) p0_weights(F, KA, 2, F.vcu * NWAVES + F.wave, F.G * NWAVES);
        if (BOTH(6)) GRID_BAR();
    }
    if (IN(7)) { PHASE_ARGS();
        pg8::Gemm g{ACT, (const bf16*)(ws + WS_W2D), MP, D, FF, FFP}; pg8::StaticOrder S; S.init(MP, D, F.G, (int)blockIdx.x);
        pg8::EpiResid<false> E{nullptr, nullptr, XB, ST3, 0.5f};
        pg8::gemm_phase<pg8::EpiResid<false>, pg8::StaticOrder, true, true>(F.lds + RING_OFF, g, S, E);
        if (BOTH(7)) GRID_BAR();
    }
    if (IN(8)) { PHASE_ARGS();
        pg8::Gemm g{XB, (const bf16*)(ws + WS_WPG), MP, D, D, D}; pg8::StaticOrder S; S.init(MP, D, F.G, (int)blockIdx.x);
        pg8::EpiPle E{ST3, F.lds + STAB_OFF, PP, XB, out};
        pg8::gemm_phase<pg8::EpiPle, pg8::StaticOrder, true, true>(F.lds + RING_OFF, g, S, E);
    }
#undef IN
#undef BOTH
#undef GRID_BAR
#undef PHASE_ARGS
}

extern "C" void kernel_launch(void* const* d_in, const int* in_sizes, int n_in, void* d_out, int out_size, void* d_ws, size_t ws_size, hipStream_t stream) {
    static int grid = 0;
    if (grid == 0) {
        if (n_in != 26 || in_sizes[0] != MP * D || (size_t)out_size != O_END || ws_size < WS_END) { fprintf(stderr, "kernel_launch: unexpected shapes: n_in %d, in0 %d, out %d, ws %zu; nothing launched\n", n_in, n_in > 0 ? in_sizes[0] : -1, out_size, ws_size); grid = -1; return; }
        int dev = 0, cus = 0, per_cu = 0;
        if (hipGetDevice(&dev) != hipSuccess || hipDeviceGetAttribute(&cus, hipDeviceAttributeMultiprocessorCount, dev) != hipSuccess) { fprintf(stderr, "kernel_launch: hipGetDevice / hipDeviceGetAttribute failed\n"); grid = -1; return; }
        if (hipFuncSetAttribute((const void*)mk_fwd, hipFuncAttributeMaxDynamicSharedMemorySize, LDS_BYTES) != hipSuccess) { fprintf(stderr, "kernel_launch: hipFuncSetAttribute failed\n"); grid = -1; return; }
        if (hipOccupancyMaxActiveBlocksPerMultiprocessor(&per_cu, (const void*)mk_fwd, NWAVES * 64, LDS_BYTES) != hipSuccess || per_cu < 1)
            fprintf(stderr, "kernel_launch: note: the occupancy query reports %d workgroups per CU\n", per_cu);
        (void)hipGetLastError();
        grid = cus;
    }
    if (grid < 0) return;
    if (hipMemsetAsync((char*)d_ws + WS_CTL, 0, CTL_ZERO_BYTES, stream) != hipSuccess) { fprintf(stderr, "kernel_launch: hipMemsetAsync failed\n"); return; }
    Args a{};
    for (int i = 0; i < 26; ++i) a.in[i] = (const float*)d_in[i];
    a.out = (float*)d_out; a.ws = (unsigned char*)d_ws;
    for (int li = 0; li < N_LAUNCHES; ++li) {
        a.ph_lo = (N_LAUNCHES == 1) ? 0 : li; a.ph_hi = (N_LAUNCHES == 1) ? NPHASE : li + 1; a.li = li;
        hipLaunchKernelGGL(mk_fwd, dim3(grid), dim3(NWAVES * 64), LDS_BYTES, stream, a);
        const hipError_t le = hipPeekAtLastError();
        if (le != hipSuccess) { fprintf(stderr, "kernel_launch: launch %d failed: %s\n", li, hipGetErrorName(le)); break; }
    }
}
```

```cpp
#include <hip/hip_runtime.h>
#include <cstdio>
#include <cstdint>

constexpr int D = 1024, FF = 2816, NIN = 2304, DPLE = 256;
constexpr int SEQ = 8192, MP = 2 * SEQ, MS = 128 * 4, M = MP + MS;
constexpr float RMS_EPS = 1e-6f;
constexpr float LOG2E = 1.4426950408889634f;
constexpr float QSCALE = 0.125f * LOG2E;
__device__ __forceinline__ float bf_lo(unsigned w) { return __uint_as_float(w << 16); }
__device__ __forceinline__ float bf_hi(unsigned w) { return __uint_as_float(w & 0xffff0000u); }
#define MK_N_LAUNCHES 1
namespace pg8 {
#define PG8_LAS __attribute__((address_space(3)))
typedef unsigned short bf16_t;
typedef short bf16x8 __attribute__((ext_vector_type(8)));
typedef float f32x4 __attribute__((ext_vector_type(4)));
typedef unsigned u32x4 __attribute__((ext_vector_type(4)));
constexpr int BM = 256, BK = 64, HALF = 128, HTB = HALF * BK * 2  , STAGE_BYTES = 8 * HTB, NXCD = 8, WGM = 8;

__host__ __device__ __forceinline__ int lds_byte(int r, int c) { const int st = (r >> 4) * 2 + (c >> 5), rr = r & 15, cc = c & 31, ob = rr * 64 + cc * 2; return st * 1024 + (ob ^ (((ob >> 9) & 1) << 5)); }
__host__ __device__ __forceinline__ void stage_rc(int b, int& R, int& C) { const int st = b / 1024, sb = b % 1024, swz = sb ^ (((sb >> 9) & 1) << 5); R = (st >> 1) * 16 + swz / 64; C = (st & 1) * 32 + (swz % 64) / 2; }
__host__ __device__ __forceinline__ int perm32(int rho) { const int n = rho >> 4, i = rho & 15; return 8 * (i >> 2) + 4 * n + (i & 3); }

struct Unit { int pm, pn; };
struct Gemm { const bf16_t* A; const bf16_t* Bt; int M, N, K; };

struct StaticOrder {
    int nM, nN, nwg, G, c;
    __host__ __device__ void init(int M, int N, int G_, int c_) { nM = M / BM; nN = N / BM; nwg = nM * nN; G = G_; c = c_; }
    __host__ __device__ bool next(int i, Unit& u) const {
        const long L = (long)i * G + c; if (L >= nwg) return false;
        int wgid = (int)L; { const int q = nwg / NXCD, r = nwg % NXCD, xcd = wgid % NXCD, off = wgid / NXCD; wgid = (xcd < r ? xcd * (q + 1) : r * (q + 1) + (xcd - r) * q) + off; }
        const int nig = WGM * nN, gid = wgid / nig, fm = gid * WGM, gsz = (nM - fm) < WGM ? (nM - fm) : WGM;
        u.pm = fm + ((wgid % nig) % gsz); u.pn = (wgid % nig) / gsz; return true;
    }
    __device__ __forceinline__ void a_ready(const Unit&) const {}
    __device__ __forceinline__ void done(const Unit&) const {}
};

__device__ __forceinline__ unsigned cvt_pk_bf16(float lo, float hi) { unsigned r; asm volatile("v_cvt_pk_bf16_f32 %0, %1, %2" : "=v"(r) : "v"(lo), "v"(hi)); return r; }
typedef float f32x2 __attribute__((ext_vector_type(2)));
__device__ __forceinline__ float row_rscale(const float* stats, int row) {
    const f32x4* p = (const f32x4*)(stats + (size_t)row * 16);
    const f32x4 a = p[0], b = p[1], c = p[2], d = p[3];
    const f32x4 s = (a + b) + (c + d);
    const float t = (s[0] + s[1]) + (s[2] + s[3]);
    return __builtin_amdgcn_rsqf(t * (1.0f / 1024.0f) + RMS_EPS);
}
__device__ __forceinline__ float row_rscale_lds(const PG8_LAS unsigned char* stab, int rowp, int fq) {
    const f32x4 a = *(const PG8_LAS f32x4*)(stab + rowp * 64 + fq * 16);
    float t = (a[0] + a[1]) + (a[2] + a[3]);
    t += __shfl_xor(t, 16); t += __shfl_xor(t, 32);
    return __builtin_amdgcn_rsqf(t * (1.0f / 1024.0f) + RMS_EPS);
}
__device__ __forceinline__ float row_rscale4(const float* stats, int row, int fq) {
    const f32x4 a = *(const f32x4*)(stats + (size_t)row * 16 + 4 * fq);
    float t = (a[0] + a[1]) + (a[2] + a[3]);
    t += __shfl_xor(t, 16); t += __shfl_xor(t, 32);
    return __builtin_amdgcn_rsqf(t * (1.0f / 1024.0f) + RMS_EPS);
}

struct EpiStoreBf16 {
    static constexpr bool PERM = true, AFTER_DRAIN = false, STATS_LDS = false, STRIP = false;
    bf16_t* O; int ldc;
    __device__ __forceinline__ void operator()(const f32x4 (&acc)[2][2][4][2], const Unit& u, int wr, int wc, int fr, int fq) const {
        const int row0 = u.pm * BM + wr * 64 + fr, col0 = u.pn * BM + wc * 32 + 8 * fq;
#pragma unroll
        for (int ai = 0; ai < 2; ++ai)
#pragma unroll
            for (int m = 0; m < 4; ++m) { bf16_t* rowp = O + (size_t)(row0 + ai * HALF + m * 16) * ldc + col0;
#pragma unroll
                for (int bj = 0; bj < 2; ++bj) { const f32x4 v0 = acc[ai][bj][m][0], v1 = acc[ai][bj][m][1];
                    u32x4 w; w.x = cvt_pk_bf16(v0[0], v0[1]); w.y = cvt_pk_bf16(v0[2], v0[3]); w.z = cvt_pk_bf16(v1[0], v1[1]); w.w = cvt_pk_bf16(v1[2], v1[3]);
                    *(u32x4*)(rowp + bj * HALF) = w; } }
    }
};

template <bool NORM> struct EpiSwiglu {
    static constexpr bool PERM = true, AFTER_DRAIN = false, STATS_LDS = NORM, STRIP = false;
    bf16_t* O; const float* stats; const PG8_LAS unsigned char* stab;
    __device__ __forceinline__ void operator()(const f32x4 (&acc)[2][2][4][2], const Unit& u, int wr, int wc, int fr, int fq) const {
        const int row0 = u.pm * BM + wr * 64 + fr, f0 = u.pn * 128 + wc * 32 + 8 * fq;
#pragma unroll
        for (int ai = 0; ai < 2; ++ai)
#pragma unroll
            for (int m = 0; m < 4; ++m) {
                const int row = row0 + ai * HALF + m * 16;
                float r = 1.0f, rinv = 1.0f; if (NORM) { r = row_rscale_lds(stab, row - u.pm * BM, fq); rinv = __builtin_amdgcn_rcpf(r); }
                float o[8];
#pragma unroll
                for (int n = 0; n < 2; ++n)
#pragma unroll
                    for (int e = 0; e < 4; ++e) { float g = acc[ai][0][m][n][e]; const float up = acc[ai][1][m][n][e];
                        if (NORM) g *= r;
                        const float ex = __builtin_amdgcn_exp2f(-g);
                        const float den = NORM ? __builtin_fmaf(ex, rinv, rinv) : 1.0f + ex;
                        o[n * 4 + e] = g * __builtin_amdgcn_rcpf(den) * up; }
                u32x4 w; w.x = cvt_pk_bf16(o[0], o[1]); w.y = cvt_pk_bf16(o[2], o[3]); w.z = cvt_pk_bf16(o[4], o[5]); w.w = cvt_pk_bf16(o[6], o[7]);
                *(u32x4*)(O + (size_t)row * FF + f0) = w;
            }
    }
};

template <bool FROM_H1> struct EpiResid {
    static constexpr bool PERM = true, AFTER_DRAIN = false, STATS_LDS = false, STRIP = true;
    const float* rms; const float* g;
    bf16_t* xb; float* stats; float alpha;
    __device__ __forceinline__ void strip(const f32x4 (&accS)[2], const Unit& u, int wr, int wc, int fr, int fq) const {
        const int row = MP + 8 * u.pm + fr, col = u.pn * BM + wr * HALF + wc * 32 + 8 * fq;
        float ss = 0.f;
        if (fr < 8) {
            const u32x4 p = *(const u32x4*)(xb + (size_t)row * D + col);
            f32x4 a0 = (f32x4){bf_lo(p.x), bf_hi(p.x), bf_lo(p.y), bf_hi(p.y)}, a1 = (f32x4){bf_lo(p.z), bf_hi(p.z), bf_lo(p.w), bf_hi(p.w)};
            if (FROM_H1) { const float rr = rms[row]; const f32x4 g0 = *(const f32x4*)(g + col), g1 = *(const f32x4*)(g + col + 4);
                a0 = a0 * rr * (f32x4){1.0f / g0[0], 1.0f / g0[1], 1.0f / g0[2], 1.0f / g0[3]}; a1 = a1 * rr * (f32x4){1.0f / g1[0], 1.0f / g1[1], 1.0f / g1[2], 1.0f / g1[3]}; }
            const f32x4 v0 = a0 + accS[0] * alpha, v1 = a1 + accS[1] * alpha;
            u32x4 w; w.x = cvt_pk_bf16(v0[0], v0[1]); w.y = cvt_pk_bf16(v0[2], v0[3]); w.z = cvt_pk_bf16(v1[0], v1[1]); w.w = cvt_pk_bf16(v1[2], v1[3]);
            *(u32x4*)(xb + (size_t)row * D + col) = w;
            ss = (v0[0] * v0[0] + v0[1] * v0[1]) + (v0[2] * v0[2] + v0[3] * v0[3]) + (v1[0] * v1[0] + v1[1] * v1[1]) + (v1[2] * v1[2] + v1[3] * v1[3]);
        }
        ss += __shfl_xor(ss, 16); ss += __shfl_xor(ss, 32);
        if (fr < 8 && fq == 0) atomicAdd(stats + (size_t)row * 16 + u.pn * 4 + wc, ss);
    }
    __device__ __forceinline__ void operator()(const f32x4 (&acc)[2][2][4][2], const Unit& u, int wr, int wc, int fr, int fq) const {
        const int row0 = u.pm * BM + wr * 64 + fr, col0 = u.pn * BM + wc * 32 + 8 * fq;
        f32x4 ig[2][2];
        if (FROM_H1) {
#pragma unroll
            for (int bj = 0; bj < 2; ++bj)
#pragma unroll
                for (int n = 0; n < 2; ++n) { const f32x4 gv = *(const f32x4*)(g + col0 + bj * HALF + 4 * n); ig[bj][n] = (f32x4){1.0f / gv[0], 1.0f / gv[1], 1.0f / gv[2], 1.0f / gv[3]}; } }
#pragma unroll
        for (int ai = 0; ai < 2; ++ai) {
            u32x4 pw[4][2]; float rr[4];
#pragma unroll
            for (int m = 0; m < 4; ++m) { const int row = row0 + ai * HALF + m * 16;
                rr[m] = 1.0f; if (FROM_H1) rr[m] = rms[row];
#pragma unroll
                for (int bj = 0; bj < 2; ++bj) pw[m][bj] = *(const u32x4*)(xb + (size_t)row * D + col0 + bj * HALF); }
#pragma unroll
            for (int m = 0; m < 4; ++m) {
                const int row = row0 + ai * HALF + m * 16;
                float ss = 0.f;
#pragma unroll
                for (int bj = 0; bj < 2; ++bj) { const int c = col0 + bj * HALF; const u32x4 p = pw[m][bj];
                    f32x4 a0 = (f32x4){bf_lo(p.x), bf_hi(p.x), bf_lo(p.y), bf_hi(p.y)}, a1 = (f32x4){bf_lo(p.z), bf_hi(p.z), bf_lo(p.w), bf_hi(p.w)};
                    if (FROM_H1) { a0 = a0 * rr[m] * ig[bj][0]; a1 = a1 * rr[m] * ig[bj][1]; }
                    const f32x4 v0 = a0 + acc[ai][bj][m][0] * alpha, v1 = a1 + acc[ai][bj][m][1] * alpha;
                    u32x4 w; w.x = cvt_pk_bf16(v0[0], v0[1]); w.y = cvt_pk_bf16(v0[2], v0[3]); w.z = cvt_pk_bf16(v1[0], v1[1]); w.w = cvt_pk_bf16(v1[2], v1[3]);
                    *(u32x4*)(xb + (size_t)row * D + c) = w;
                    ss += (v0[0] * v0[0] + v0[1] * v0[1]) + (v0[2] * v0[2] + v0[3] * v0[3]) + (v1[0] * v1[0] + v1[1] * v1[1]) + (v1[2] * v1[2] + v1[3] * v1[3]); }
                ss += __shfl_xor(ss, 16); ss += __shfl_xor(ss, 32);
                if (fq == 0) stats[(size_t)row * 16 + u.pn * 4 + wc] = ss;
            }
        }
    }
};

struct EpiIn {
    static constexpr bool PERM = true, AFTER_DRAIN = false, STATS_LDS = true, STRIP = false;
    const float* stats; const PG8_LAS unsigned char* stab; const float* qn; const float* kn;
    bf16_t *Q, *Kb, *Vb, *Gb, *Ub;
    float *kwinP, *vwinP, *convP, *kwinS, *vwinS, *convS;
    __device__ __forceinline__ void operator()(const f32x4 (&acc)[2][2][4][2], const Unit& u, int wr, int wc, int fr, int fq) const {
        const int row0 = u.pm * BM + wr * 64 + fr, pn = u.pn;
        f32x4 gn[2][2];
        if (pn < 3) { const float* gp = (pn < 2) ? qn : kn;
#pragma unroll
            for (int bj = 0; bj < 2; ++bj)
#pragma unroll
                for (int n = 0; n < 2; ++n) gn[bj][n] = *(const f32x4*)(gp + 32 * bj + 8 * fq + 4 * n); }
#pragma unroll
        for (int ai = 0; ai < 2; ++ai)
#pragma unroll
            for (int m = 0; m < 4; ++m) {
                const int row = row0 + ai * HALF + m * 16;
                const float r = row_rscale_lds(stab, row - u.pm * BM, fq);
                f32x4 z[2][2];
#pragma unroll
                for (int bj = 0; bj < 2; ++bj)
#pragma unroll
                    for (int n = 0; n < 2; ++n) z[bj][n] = acc[ai][bj][m][n] * r;
                if (pn < 3) {
                    const bool isv = (pn == 2 && wc >= 2);
                    if (!isv) {
                        float ss = 0.f;
#pragma unroll
                        for (int bj = 0; bj < 2; ++bj)
#pragma unroll
                            for (int n = 0; n < 2; ++n) ss += (z[bj][n][0] * z[bj][n][0] + z[bj][n][1] * z[bj][n][1]) + (z[bj][n][2] * z[bj][n][2] + z[bj][n][3] * z[bj][n][3]);
                        ss += __shfl_xor(ss, 16); ss += __shfl_xor(ss, 32);
                        float rq = __builtin_amdgcn_rsqf(ss * (1.0f / 64.0f) + RMS_EPS); if (pn < 2) rq *= QSCALE;
#pragma unroll
                        for (int bj = 0; bj < 2; ++bj)
#pragma unroll
                            for (int n = 0; n < 2; ++n) z[bj][n] = z[bj][n] * rq * gn[bj][n];
                    }
                    bf16_t* dst; float* win = nullptr;
                    if (pn < 2) dst = Q + (size_t)row * 512 + (pn * 4 + wc) * 64 + 8 * fq;
                    else { const int kvh = wc & 1; dst = (isv ? Vb : Kb) + (size_t)row * 128 + kvh * 64 + 8 * fq;
                        if (row < MP) { const int t = row & (SEQ - 1); if (t >= SEQ - 128) win = (isv ? vwinP : kwinP) + ((size_t)(((row >> 13) * 128 + (t - (SEQ - 128))) * 2 + kvh)) * 64 + 8 * fq; }
                        else { const int i = row - MP; win = (isv ? vwinS : kwinS) + ((size_t)(((i >> 2) * 128 + 124 + (i & 3)) * 2 + kvh)) * 64 + 8 * fq; } }
#pragma unroll
                    for (int bj = 0; bj < 2; ++bj) { const f32x4 v0 = z[bj][0], v1 = z[bj][1];
                        u32x4 w; w.x = cvt_pk_bf16(v0[0], v0[1]); w.y = cvt_pk_bf16(v0[2], v0[3]); w.z = cvt_pk_bf16(v1[0], v1[1]); w.w = cvt_pk_bf16(v1[2], v1[3]);
                        *(u32x4*)(dst + 32 * bj) = w;
                        if (win) { *(f32x4*)(win + 32 * bj) = v0; *(f32x4*)(win + 32 * bj + 4) = v1; } }
                } else if (pn < 5) {
                    bf16_t* dst = Gb + (size_t)row * 512 + (pn - 3) * 256 + wc * 32 + 8 * fq;
#pragma unroll
                    for (int bj = 0; bj < 2; ++bj) { const f32x4 v0 = z[bj][0], v1 = z[bj][1];
                        u32x4 w; w.x = cvt_pk_bf16(v0[0], v0[1]); w.y = cvt_pk_bf16(v0[2], v0[3]); w.z = cvt_pk_bf16(v1[0], v1[1]); w.w = cvt_pk_bf16(v1[2], v1[3]);
                        *(u32x4*)(dst + bj * HALF) = w; }
                } else {
                    const int f0 = (pn - 5) * 128 + wc * 32 + 8 * fq;
                    const f32x4 v0 = z[0][0] * z[1][0], v1 = z[0][1] * z[1][1];
                    u32x4 w; w.x = cvt_pk_bf16(v0[0], v0[1]); w.y = cvt_pk_bf16(v0[2], v0[3]); w.z = cvt_pk_bf16(v1[0], v1[1]); w.w = cvt_pk_bf16(v1[2], v1[3]);
                    *(u32x4*)(Ub + (size_t)row * 512 + f0) = w;
                    float* cs = nullptr;
                    if (row < MP) { const int t = row & (SEQ - 1); if (t >= SEQ - 2) cs = convP + (size_t)((row >> 13) * 2 + (t - (SEQ - 2))) * 512 + f0; }
                    else { const int i = row - MP; if ((i & 3) >= 2) cs = convS + (size_t)((i >> 2) * 2 + ((i & 3) - 2)) * 512 + f0; }
                    if (cs) { *(f32x4*)cs = v0; *(f32x4*)(cs + 4) = v1; }
                }
            }
    }
};

struct EpiPle {
    static constexpr bool PERM = true, AFTER_DRAIN = false, STATS_LDS = true, STRIP = true;
    const float* stats; const PG8_LAS unsigned char* stab; const bf16_t* pp; const bf16_t* xb; float* out;
    __device__ __forceinline__ void strip(const f32x4 (&accS)[2], const Unit& u, int wr, int wc, int fr, int fq) const {
        if (fr < 8) {
            const int row = MP + 8 * u.pm + fr, col = u.pn * BM + wr * HALF + wc * 32 + 8 * fq;
            const float r = row_rscale(stats, row) * LOG2E;
            const size_t off = (size_t)row * D + col;
            const u32x4 x = *(const u32x4*)(xb + off), p = *(const u32x4*)(pp + off);
            const f32x4 x0 = (f32x4){bf_lo(x.x), bf_hi(x.x), bf_lo(x.y), bf_hi(x.y)}, x1 = (f32x4){bf_lo(x.z), bf_hi(x.z), bf_lo(x.w), bf_hi(x.w)};
            const f32x4 p0 = (f32x4){bf_lo(p.x), bf_hi(p.x), bf_lo(p.y), bf_hi(p.y)}, p1 = (f32x4){bf_lo(p.z), bf_hi(p.z), bf_lo(p.w), bf_hi(p.w)};
            f32x4 y0, y1;
#pragma unroll
            for (int e = 0; e < 4; ++e) { y0[e] = x0[e] + __builtin_amdgcn_rcpf(1.0f + __builtin_amdgcn_exp2f(-accS[0][e] * r)) * p0[e];
                                          y1[e] = x1[e] + __builtin_amdgcn_rcpf(1.0f + __builtin_amdgcn_exp2f(-accS[1][e] * r)) * p1[e]; }
            *(f32x4*)(out + off) = y0; *(f32x4*)(out + off + 4) = y1;
        }
    }
    __device__ __forceinline__ void operator()(const f32x4 (&acc)[2][2][4][2], const Unit& u, int wr, int wc, int fr_, int fq_) const {
        int fr = fr_, fq = fq_; asm volatile("" : "+v"(fr), "+v"(fq));
        const int row0 = u.pm * BM + wr * 64 + fr, col0 = u.pn * BM + wc * 32 + 8 * fq;
#pragma unroll
        for (int am = 0; am < 4; ++am) { const int ai = am >> 1;
            u32x4 xw[4][2], pw[4][2];
#pragma unroll
            for (int m = 2 * (am & 1); m < 2 * (am & 1) + 2; ++m)
#pragma unroll
                for (int bj = 0; bj < 2; ++bj) { const size_t off = (size_t)(row0 + ai * HALF + m * 16) * D + col0 + bj * HALF; xw[m][bj] = *(const u32x4*)(xb + off); pw[m][bj] = *(const u32x4*)(pp + off); }
#pragma unroll
            for (int m = 2 * (am & 1); m < 2 * (am & 1) + 2; ++m) {
                const int row = row0 + ai * HALF + m * 16;
                const float r = row_rscale_lds(stab, row - u.pm * BM, fq) * LOG2E;
#pragma unroll
                for (int bj = 0; bj < 2; ++bj) { const size_t off = (size_t)row * D + col0 + bj * HALF; const u32x4 x = xw[m][bj], p = pw[m][bj];
                    const f32x4 x0 = (f32x4){bf_lo(x.x), bf_hi(x.x), bf_lo(x.y), bf_hi(x.y)}, x1 = (f32x4){bf_lo(x.z), bf_hi(x.z), bf_lo(x.w), bf_hi(x.w)};
                    const f32x4 p0 = (f32x4){bf_lo(p.x), bf_hi(p.x), bf_lo(p.y), bf_hi(p.y)}, p1 = (f32x4){bf_lo(p.z), bf_hi(p.z), bf_lo(p.w), bf_hi(p.w)};
                    f32x4 y0, y1;
#pragma unroll
                    for (int e = 0; e < 4; ++e) { y0[e] = x0[e] + __builtin_amdgcn_rcpf(1.0f + __builtin_amdgcn_exp2f(-acc[ai][bj][m][0][e] * r)) * p0[e];
                                                  y1[e] = x1[e] + __builtin_amdgcn_rcpf(1.0f + __builtin_amdgcn_exp2f(-acc[ai][bj][m][1][e] * r)) * p1[e]; }
                    *(f32x4*)(out + off) = y0; *(f32x4*)(out + off + 4) = y1; }
            }
        }
    }
};

template <class Epi, class Sched, bool ALIGN_EPI = false, bool SP2 = false>
__device__ __forceinline__ void gemm_phase(PG8_LAS unsigned char* lds, const Gemm g, const Sched& S, const Epi& E) {
    int tid_ = threadIdx.x; asm volatile("" : "+v"(tid_));
    const int tid = tid_, wid = __builtin_amdgcn_readfirstlane(tid >> 6), lane = tid & 63, wr = wid >> 2, wc = wid & 3, fr = lane & 15, fq = lane >> 4;
    const int K = g.K, nt = K / BK;
    unsigned voffA[2], voffB[2];
#pragma unroll
    for (int i = 0; i < 2; ++i) { int R, C; stage_rc(tid * 16 + i * 8192, R, C); const int Rb = Epi::PERM ? ((R & ~31) + perm32(R & 31)) : R;
        voffA[i] = (unsigned)(R * K + C) * 2u; voffB[i] = (unsigned)(Rb * K + C) * 2u; }
    const unsigned kstep = (unsigned)(BK * 2);
    const unsigned hstep = (unsigned)HALF * K * 2;
    const unsigned tstep = 2 * hstep;
    const unsigned ldsw = (unsigned)wid * 1024u;
    const int aoff = lds_byte(wr * 64 + fr, fq * 8), boff = lds_byte(wc * 32 + fr, fq * 8);
#define PG8_SA(b, h) (((b) * 2 + (h)) * HTB)
#define PG8_SB(b, h) ((4 + (b) * 2 + (h)) * HTB)
    const __amdgpu_buffer_rsrc_t rA = __builtin_amdgcn_make_buffer_rsrc((void*)g.A, 0, -1, 0x00020000), rB = __builtin_amdgcn_make_buffer_rsrc((void*)g.Bt, 0, -1, 0x00020000);
#define PG8_STAGE(bufoff, goff, voff, rs) do { _Pragma("unroll") for (int _i = 0; _i < 2; ++_i) \
        __builtin_amdgcn_raw_ptr_buffer_load_lds(rs, (PG8_LAS unsigned*)(lds + (bufoff) + ldsw + _i * 8192), 16, (int)(voff)[_i], (int)(goff), 0, 0); } while (0)
#define PG8_LDA(dst, b, h) do { _Pragma("unroll") for (int m = 0; m < 4; ++m) _Pragma("unroll") for (int k = 0; k < 2; ++k) dst[m][k] = *(const PG8_LAS bf16x8*)(lds + PG8_SA(b, h) + aoff + m * 2048 + k * 1024); } while (0)
#define PG8_LDB(dst, b, h) do { _Pragma("unroll") for (int n = 0; n < 2; ++n) _Pragma("unroll") for (int k = 0; k < 2; ++k) dst[n][k] = *(const PG8_LAS bf16x8*)(lds + PG8_SB(b, h) + boff + n * 2048 + k * 1024); } while (0)
#define PG8_MMA(ai, bj, At, Bt) do { __builtin_amdgcn_s_setprio(1); _Pragma("unroll") for (int m = 0; m < 4; ++m) _Pragma("unroll") for (int n = 0; n < 2; ++n) _Pragma("unroll") for (int k = 0; k < 2; ++k) \
        acc[ai][bj][m][n] = __builtin_amdgcn_mfma_f32_16x16x32_bf16(Bt[n][k], At[m][k], acc[ai][bj][m][n], 0, 0, 0); __builtin_amdgcn_s_setprio(0); } while (0)
#define PG8_WAIT_V(n) asm volatile("s_waitcnt vmcnt(" #n ")" ::: "memory")
#define PG8_WAIT_L(n) asm volatile("s_waitcnt lgkmcnt(" #n ")" ::: "memory")
#define PG8_BAR __builtin_amdgcn_s_barrier()
#define PG8_SCHED __builtin_amdgcn_sched_barrier(0)
    constexpr int STRIP_OFF = STAGE_BYTES + 16384;
    const int srow_ = 8 * (wid & 1) + (lane >> 3);
    const unsigned voffS = (unsigned)(srow_ * K) * 2u + (unsigned)(((lane & 7) ^ (srow_ & 7)) * 16);
    const int soff0 = fr * 128 + ((fq ^ (fr & 7)) << 4);
#define PG8_STAGES(b, goff) do { if constexpr (Epi::STRIP) { if (wid < 2) __builtin_amdgcn_raw_ptr_buffer_load_lds(rA, (PG8_LAS unsigned*)(lds + STRIP_OFF + (b) * 2048 + wid * 1024), 16, (int)voffS, (int)(goff), 0, 0); } } while (0)
#define PG8_LDS(b) do { if constexpr (Epi::STRIP) { Sf[0] = *(const PG8_LAS bf16x8*)(lds + STRIP_OFF + (b) * 2048 + soff0); Sf[1] = *(const PG8_LAS bf16x8*)(lds + STRIP_OFF + (b) * 2048 + (soff0 ^ 64)); } } while (0)
#define PG8_MMAS() do { if constexpr (Epi::STRIP) { if (wr == 0) { _Pragma("unroll") for (int n = 0; n < 2; ++n) _Pragma("unroll") for (int k = 0; k < 2; ++k) accS[n] = __builtin_amdgcn_mfma_f32_16x16x32_bf16(B0[n][k], Sf[k], accS[n], 0, 0, 0); } \
        else { _Pragma("unroll") for (int n = 0; n < 2; ++n) _Pragma("unroll") for (int k = 0; k < 2; ++k) accS[n] = __builtin_amdgcn_mfma_f32_16x16x32_bf16(B1[n][k], Sf[k], accS[n], 0, 0, 0); } } } while (0)
    static_assert(!Epi::STRIP || SP2, "the sample-row strip lives in the SP2 loop");
    Unit cur, nxt; int ui = 0;
    if (!S.next(0, cur)) return;
    f32x4 accS[2] = {(f32x4){0.f, 0.f, 0.f, 0.f}, (f32x4){0.f, 0.f, 0.f, 0.f}}; bf16x8 Sf[2];
    f32x4 acc[2][2][4][2];
#pragma unroll
    for (int a = 0; a < 2; ++a)
#pragma unroll
        for (int b = 0; b < 2; ++b)
#pragma unroll
            for (int m = 0; m < 4; ++m)
#pragma unroll
                for (int n = 0; n < 2; ++n) acc[a][b][m][n] = (f32x4){0.f, 0.f, 0.f, 0.f};
    bf16x8 At[4][2], B0[2][2], B1[2][2];
    unsigned cA = (unsigned)cur.pm * tstep, cB = (unsigned)cur.pn * tstep;
    unsigned cS = (unsigned)(MP + 8 * cur.pm) * K * 2;
    S.a_ready(cur);
    if constexpr (SP2) {
        PG8_STAGE(PG8_SB(0, 0), cB, voffB, rB); PG8_STAGE(PG8_SB(0, 1), cB + hstep, voffB, rB); PG8_STAGE(PG8_SA(0, 0), cA, voffA, rA); PG8_STAGES(0, cS); PG8_STAGE(PG8_SA(0, 1), cA + hstep, voffA, rA);
        if (wr == 1) PG8_BAR;
        PG8_WAIT_V(2); PG8_BAR;
        PG8_STAGE(PG8_SB(1, 0), cB + kstep, voffB, rB); PG8_STAGE(PG8_SA(1, 0), cA + kstep, voffA, rA); PG8_STAGES(1, cS + kstep); PG8_STAGE(PG8_SB(1, 1), cB + hstep + kstep, voffB, rB);
        PG8_WAIT_V(6); PG8_BAR;
    } else {
        PG8_STAGE(PG8_SB(0, 0), cB, voffB, rB); PG8_STAGE(PG8_SA(0, 0), cA, voffA, rA); PG8_STAGE(PG8_SB(0, 1), cB + hstep, voffB, rB); PG8_STAGE(PG8_SA(0, 1), cA + hstep, voffA, rA);
        if (wr == 1) PG8_BAR;
        PG8_WAIT_V(4); PG8_BAR;
        PG8_STAGE(PG8_SB(1, 0), cB + kstep, voffB, rB); PG8_STAGE(PG8_SA(1, 0), cA + kstep, voffA, rA); PG8_STAGE(PG8_SB(1, 1), cB + hstep + kstep, voffB, rB);
        PG8_WAIT_V(6); PG8_BAR;
    }
    for (;;) {
        const bool has_next = S.next(ui + 1, nxt);
        const unsigned nA = has_next ? (unsigned)nxt.pm * tstep : cA, nB = has_next ? (unsigned)nxt.pn * tstep : cB;
        const unsigned nS = has_next ? (unsigned)(MP + 8 * nxt.pm) * K * 2 : cS;
        for (int t = 0; t < nt; t += 2) {
            const bool last = (t == nt - 2);
            const unsigned a1 = cA + (unsigned)(t + 1) * kstep;
            const unsigned a2 = last ? nA : cA + (unsigned)(t + 2) * kstep, b2 = last ? nB : cB + (unsigned)(t + 2) * kstep;
            const unsigned a3 = a2 + kstep, b3 = b2 + kstep;
            const unsigned s2 = last ? nS : cS + (unsigned)(t + 2) * kstep, s3 = s2 + kstep;
            if (last && has_next) S.a_ready(nxt);
            if constexpr (Epi::STATS_LDS) { if (last) {
                int l_ = lane; asm volatile("" : "+v"(l_));
                const char* sp = (const char*)E.stats + (size_t)cur.pm * (BM * 64) + (size_t)(wid * 2048 + l_ * 16);
#pragma unroll
                for (int _i = 0; _i < 2; ++_i) __builtin_amdgcn_global_load_lds((const unsigned*)(sp + _i * 1024), (PG8_LAS unsigned*)(lds + STAGE_BYTES + wid * 2048 + _i * 1024), 16, 0, 0); } }
            if constexpr (SP2) {
            PG8_LDB(B0, 0, 0); PG8_LDB(B1, 0, 1); PG8_SCHED; PG8_LDA(At, 0, 0); PG8_LDS(0); PG8_STAGE(PG8_SA(1, 1), a1 + hstep, voffA, rA);
            PG8_WAIT_V(8); PG8_WAIT_L(0); PG8_BAR; PG8_MMA(0, 0, At, B0); PG8_MMA(0, 1, At, B1); PG8_MMAS(); PG8_BAR; PG8_SCHED;
            PG8_LDA(At, 0, 1); PG8_STAGE(PG8_SB(0, 0), b2, voffB, rB); PG8_STAGE(PG8_SB(0, 1), b2 + hstep, voffB, rB); PG8_STAGE(PG8_SA(0, 0), a2, voffA, rA); PG8_STAGES(0, s2);
            PG8_WAIT_V(8); PG8_WAIT_L(0); PG8_BAR; PG8_MMA(1, 0, At, B0); PG8_MMA(1, 1, At, B1); PG8_BAR; PG8_SCHED;
            PG8_LDB(B0, 1, 0); PG8_LDB(B1, 1, 1); PG8_SCHED; PG8_LDA(At, 1, 0); PG8_LDS(1); PG8_STAGE(PG8_SA(0, 1), a2 + hstep, voffA, rA);
            PG8_WAIT_V(8); PG8_WAIT_L(0); PG8_BAR; PG8_MMA(0, 0, At, B0); PG8_MMA(0, 1, At, B1); PG8_MMAS(); PG8_BAR; PG8_SCHED;
            PG8_LDA(At, 1, 1); PG8_STAGE(PG8_SB(1, 0), b3, voffB, rB); PG8_STAGE(PG8_SB(1, 1), b3 + hstep, voffB, rB); PG8_STAGE(PG8_SA(1, 0), a3, voffA, rA); PG8_STAGES(1, s3);
            PG8_WAIT_V(8); PG8_WAIT_L(0); PG8_BAR; PG8_MMA(1, 0, At, B0); PG8_MMA(1, 1, At, B1); PG8_BAR; PG8_SCHED;
            } else {
            PG8_LDB(B0, 0, 0); PG8_SCHED; PG8_LDA(At, 0, 0); PG8_STAGE(PG8_SA(1, 1), a1 + hstep, voffA, rA);
            PG8_WAIT_L(8); PG8_BAR; PG8_WAIT_L(0); PG8_MMA(0, 0, At, B0); PG8_BAR; PG8_SCHED;
            PG8_LDB(B1, 0, 1); PG8_STAGE(PG8_SB(0, 0), b2, voffB, rB);
            PG8_BAR; PG8_WAIT_L(0); PG8_MMA(0, 1, At, B1); PG8_BAR;
            PG8_LDA(At, 0, 1); PG8_STAGE(PG8_SA(0, 0), a2, voffA, rA);
            PG8_BAR; PG8_WAIT_L(0); PG8_MMA(1, 0, At, B0); PG8_BAR; PG8_SCHED;
            PG8_STAGE(PG8_SB(0, 1), b2 + hstep, voffB, rB);
            PG8_WAIT_V(6); PG8_BAR; PG8_MMA(1, 1, At, B1); PG8_BAR;
            PG8_LDB(B0, 1, 0); PG8_SCHED; PG8_LDA(At, 1, 0); PG8_STAGE(PG8_SA(0, 1), a2 + hstep, voffA, rA);
            PG8_WAIT_L(8); PG8_BAR; PG8_WAIT_L(0); PG8_MMA(0, 0, At, B0); PG8_BAR; PG8_SCHED;
            PG8_LDB(B1, 1, 1); PG8_STAGE(PG8_SB(1, 0), b3, voffB, rB);
            PG8_BAR; PG8_WAIT_L(0); PG8_MMA(0, 1, At, B1); PG8_BAR;
            PG8_LDA(At, 1, 1); PG8_STAGE(PG8_SA(1, 0), a3, voffA, rA);
            PG8_BAR; PG8_WAIT_L(0); PG8_MMA(1, 0, At, B0); PG8_BAR; PG8_SCHED;
            PG8_STAGE(PG8_SB(1, 1), b3 + hstep, voffB, rB);
            PG8_WAIT_V(6); PG8_BAR; PG8_MMA(1, 1, At, B1); PG8_BAR;
            }
        }
        if constexpr (ALIGN_EPI) { if (wr == 0) PG8_BAR; }
        if constexpr (!Epi::AFTER_DRAIN) { E(acc, cur, wr, wc, fr, fq); if constexpr (Epi::STRIP) { E.strip(accS, cur, wr, wc, fr, fq); accS[0] = (f32x4){0.f, 0.f, 0.f, 0.f}; accS[1] = accS[0]; } S.done(cur); }
        if (!has_next) break;
#pragma unroll
        for (int a = 0; a < 2; ++a)
#pragma unroll
            for (int b = 0; b < 2; ++b)
#pragma unroll
                for (int m = 0; m < 4; ++m)
#pragma unroll
                    for (int n = 0; n < 2; ++n) acc[a][b][m][n] = (f32x4){0.f, 0.f, 0.f, 0.f};
        cur = nxt; cA = nA; cB = nB; cS = nS; ++ui;
        if constexpr (ALIGN_EPI) { if (wr == 1) PG8_BAR; }
    }
    PG8_WAIT_V(0);
    if constexpr (!ALIGN_EPI) { if (wr == 0) PG8_BAR; }
    PG8_BAR;
    if constexpr (Epi::AFTER_DRAIN) { E.fused(acc, cur, wr, wc, fr, fq, lds, wid, lane); S.done(cur); }
#undef PG8_SA
#undef PG8_SB
#undef PG8_STAGE
#undef PG8_STAGES
#undef PG8_LDS
#undef PG8_MMAS
#undef PG8_LDA
#undef PG8_LDB
#undef PG8_MMA
#undef PG8_WAIT_V
#undef PG8_WAIT_L
#undef PG8_BAR
#undef PG8_SCHED
}
}
#define GAS __attribute__((address_space(1)))
#define LAS __attribute__((address_space(3)))
typedef unsigned short bf16;
typedef unsigned v4u __attribute__((ext_vector_type(4)));
typedef float f32x4 __attribute__((ext_vector_type(4)));
typedef short bf16x8 __attribute__((ext_vector_type(8)));
typedef GAS unsigned gu32;
typedef GAS unsigned long long gu64;
#define RLX_AGENT __ATOMIC_RELAXED, __HIP_MEMORY_SCOPE_AGENT
#define LDS_WAIT() asm volatile("s_waitcnt lgkmcnt(0)" ::: "memory")
#define VM_WAIT() asm volatile("s_waitcnt vmcnt(0)" ::: "memory")
__device__ __forceinline__ unsigned long long rt() { return __builtin_amdgcn_s_memrealtime(); }
__device__ __forceinline__ unsigned f2bf(float f) { unsigned u = __builtin_bit_cast(unsigned, f); return (u + 0x7fffu + ((u >> 16) & 1u)) >> 16; }
__device__ __forceinline__ unsigned pk2(float lo, float hi) { return f2bf(lo) | (f2bf(hi) << 16); }

#define XB_TMO      128
#define XB_XCNT(j)  (256  + 64 * (j))
#define XB_XSUB(j)  (1280 + 64 * (j))
#define XB_XGEN(j)  (2304 + 64 * (j))
#define XB_TOP      3328
#define XB_TOPGEN   3392
#define XCD_BAR_WORDS 3456
#define XB_SPIN_CAP (1u << 18)

__device__ __forceinline__ unsigned xb_ld(unsigned* p)              { return __hip_atomic_load(p, __ATOMIC_RELAXED, __HIP_MEMORY_SCOPE_AGENT); }
__device__ __forceinline__ unsigned xb_add(unsigned* p, unsigned v) { return __hip_atomic_fetch_add(p, v, __ATOMIC_RELAXED, __HIP_MEMORY_SCOPE_AGENT); }
__device__ __forceinline__ unsigned xb_xcc_id() { return (unsigned)__builtin_amdgcn_s_getreg((3 << 11) | 20) & 0xFu; }
#define XB_SPIN(cond, bar) do { unsigned _sp = 0; while (cond) { __builtin_amdgcn_s_sleep(1); \
    if ((++_sp & 255u) == 0u) { if (xb_ld(&(bar)[XB_TMO])) break; if (_sp > XB_SPIN_CAP) { atomicAdd(&(bar)[XB_TMO], 1u); break; } } } } while (0)

struct XcdBarrier {
    unsigned* bar; unsigned x;
    volatile LAS unsigned* st;
};

__device__ __forceinline__ XcdBarrier xcd_barrier_post(unsigned* bar, volatile LAS unsigned* st) {
    XcdBarrier b; b.bar = bar; b.x = xb_xcc_id(); b.st = st;
    if (threadIdx.x == 0) (void)xb_add(&bar[XB_XCNT(b.x)], 1u);
    return b;
}
__device__ __forceinline__ void xcd_barrier_complete(unsigned* bar, unsigned x, unsigned& nloc, unsigned& nx) {
    const unsigned G = gridDim.x * gridDim.y * gridDim.z;
    unsigned sum, cnt, mine, sp = 0u;
    for (;;) {
        sum = 0u; cnt = 0u; mine = 0u;
#pragma unroll
        for (unsigned j = 0; j < 16; ++j) { const unsigned c = xb_ld(&bar[XB_XCNT(j)]); sum += c; cnt += (c > 0u) ? 1u : 0u; mine = (j == x) ? c : mine; }
        if (sum == G) break;
        __builtin_amdgcn_s_sleep(1);
        if ((++sp & 255u) == 0u) { if (xb_ld(&bar[XB_TMO])) break; if (sp > XB_SPIN_CAP) { atomicAdd(&bar[XB_TMO], 1u); break; } }
    }
    nloc = mine > 0u ? mine : 1u; nx = cnt > 0u ? cnt : 1u;
}

__device__ __forceinline__ void xcd_barrier(const XcdBarrier& b) {
    asm volatile("s_waitcnt vmcnt(0)" ::: "memory");
    __syncthreads();
    if (threadIdx.x == 0) {
        unsigned* bar = b.bar;
        __builtin_amdgcn_s_waitcnt(0);
        unsigned nloc = b.st[0], nx = b.st[1];
        if (nloc == 0u) { xcd_barrier_complete(bar, b.x, nloc, nx); b.st[0] = nloc; b.st[1] = nx; }
        const unsigned old = xb_add(&bar[XB_XSUB(b.x)], 1u);
        const unsigned gen = old / nloc;
        if (old + 1u == (gen + 1u) * nloc) {
            __builtin_amdgcn_fence(__ATOMIC_RELEASE, "agent");
            asm volatile("s_waitcnt vmcnt(0)" ::: "memory");
            const unsigned og = xb_add(&bar[XB_TOP], 1u);
            const unsigned tg = og / nx;
            if (og + 1u == (tg + 1u) * nx) xb_add(&bar[XB_TOPGEN], 1u);
            asm volatile("buffer_inv sc1" ::: "memory");
            if (og + 1u != (tg + 1u) * nx) XB_SPIN(xb_ld(&bar[XB_TOPGEN]) == tg, bar);
            xb_add(&bar[XB_XGEN(b.x)], 1u);
            asm volatile("s_waitcnt vmcnt(0)" ::: "memory");
        } else {
            asm volatile("buffer_inv sc1" ::: "memory");
            XB_SPIN(xb_ld(&bar[XB_XGEN(b.x)]) == gen, bar);
            asm volatile("s_waitcnt vmcnt(0)" ::: "memory");
        }
    }
    __syncthreads();
}
namespace att {
typedef short bf16x8 __attribute__((ext_vector_type(8)));
typedef short s16x4 __attribute__((ext_vector_type(4)));
typedef float f32x16 __attribute__((ext_vector_type(16)));
typedef float f32x4 __attribute__((ext_vector_type(4)));
typedef unsigned u32x4 __attribute__((ext_vector_type(4)));
typedef unsigned u32x2 __attribute__((ext_vector_type(2)));
typedef unsigned short bf16_t;
#define ATT_LAS __attribute__((address_space(3)))
constexpr int KCH = 4112;
constexpr int VDH = 16384 + 64;
constexpr int BIASW = 192;
constexpr int L_K = 0, L_V = 8 * KCH, L_BIAS = L_V + 2 * VDH, L_END = L_BIAS + 8 * BIASW * 4;
static_assert(L_V % 16 == 0 && L_BIAS % 16 == 0 && L_END <= 131072, "attention LDS map");
__device__ __forceinline__ int crow(int r, int hi) { return (r & 3) + 8 * (r >> 2) + 4 * hi; }
__device__ __forceinline__ unsigned cvtpk(float lo, float hi) { unsigned r; asm volatile("v_cvt_pk_bf16_f32 %0, %1, %2" : "=v"(r) : "v"(lo), "v"(hi)); return r; }
__device__ __forceinline__ s16x4 vtr(const ATT_LAS unsigned char* p) { typedef short v4i16_t __attribute__((ext_vector_type(4))); return __builtin_bit_cast(s16x4, __builtin_amdgcn_ds_read_tr16_b64_v4i16((ATT_LAS v4i16_t*)p)); }

struct Tensors {
    const bf16_t *Q, *Kb, *Vb, *Gb, *Ub, *CK, *CV;
    bf16_t* MIX;
    const float *wconv, *sconv, *sinks, *relb;
};

template <bool FULL>
__device__ __forceinline__ void wave_unit(const Tensors& T, ATT_LAS unsigned char* lds, const bf16x8 (&qf)[4], int g, int head, int ql, int r32, int hi, int lane, bool do_store, size_t orow) {
    f32x16 s[5];
    const ATT_LAS unsigned char* kbase = lds + L_K + hi * KCH + (32 * g + r32) * 16;
    const ATT_LAS float* bt = (const ATT_LAS float*)(lds + L_BIAS) + head * BIASW + (ql - 4 * hi);
#pragma unroll
    for (int t = 0; t < 5; ++t) {
#pragma unroll
        for (int r = 0; r < 16; ++r) s[t][r] = bt[160 - 32 * t - ((r & 3) + 8 * (r >> 2))];
#pragma unroll
        for (int ks = 0; ks < 4; ++ks) { const bf16x8 kf = *(const ATT_LAS bf16x8*)(kbase + 2 * ks * KCH + t * 512); s[t] = __builtin_amdgcn_mfma_f32_32x32x16_bf16(kf, qf[ks], s[t], 0, 0, 0); }
    }
    const float sink2 = T.sinks[head] * LOG2E;
    const int qc = ql - 4 * hi;
    float mx = -1e30f;
#pragma unroll
    for (int t = 0; t < 5; ++t)
#pragma unroll
        for (int r = 0; r < 16; ++r) {
            const int c0 = (r & 3) + 8 * (r >> 2);
            float v = s[t][r];
            if (t == 0) v = (c0 > qc) ? v : -1e30f;
            if (t == 4) v = (c0 <= qc) ? v : -1e30f;
            if (!FULL) { if (32 * g + 32 * t + 31 < 128) v = -1e30f; else if (32 * g + 32 * t < 128) v = (32 * g + 32 * t + c0 + 4 * hi >= 128) ? v : -1e30f; }
            s[t][r] = v; mx = fmaxf(mx, v);
        }
    mx = fmaxf(mx, __shfl_xor(mx, 32)); mx = fmaxf(mx, sink2);
#pragma unroll
    for (int t = 0; t < 5; ++t)
#pragma unroll
        for (int r = 0; r < 16; ++r) s[t][r] = __builtin_amdgcn_exp2f(s[t][r] - mx);
    f32x16 o[2], os;
    o[0] = (f32x16){0.f, 0.f, 0.f, 0.f, 0.f, 0.f, 0.f, 0.f, 0.f, 0.f, 0.f, 0.f, 0.f, 0.f, 0.f, 0.f}; o[1] = o[0]; os = o[0];
    const bf16x8 ones = (bf16x8){0x3F80, 0x3F80, 0x3F80, 0x3F80, 0x3F80, 0x3F80, 0x3F80, 0x3F80};
    const ATT_LAS unsigned char* vbase = lds + L_V + (32 * g + 4 * hi + ((lane & 15) >> 2)) * 64 + ((lane >> 4) & 1) * 32 + (lane & 3) * 8;
#pragma unroll
    for (int t = 0; t < 5; ++t)
#pragma unroll
        for (int ks = 0; ks < 2; ++ks) {
            u32x4 pw; pw.x = cvtpk(s[t][8 * ks + 0], s[t][8 * ks + 1]); pw.y = cvtpk(s[t][8 * ks + 2], s[t][8 * ks + 3]); pw.z = cvtpk(s[t][8 * ks + 4], s[t][8 * ks + 5]); pw.w = cvtpk(s[t][8 * ks + 6], s[t][8 * ks + 7]);
            const bf16x8 pf = __builtin_bit_cast(bf16x8, pw);
            os = __builtin_amdgcn_mfma_f32_32x32x16_bf16(ones, pf, os, 0, 0, 0);
#pragma unroll
            for (int dt = 0; dt < 2; ++dt) {
                const ATT_LAS unsigned char* vp = vbase + dt * VDH + (32 * t + 16 * ks) * 64;
                const s16x4 lo = vtr(vp), hh = vtr(vp + 512);
                const bf16x8 vf = (bf16x8){lo[0], lo[1], lo[2], lo[3], hh[0], hh[1], hh[2], hh[3]};
                o[dt] = __builtin_amdgcn_mfma_f32_32x32x16_bf16(vf, pf, o[dt], 0, 0, 0);
            }
        }
    const float rl = __builtin_amdgcn_rcpf(os[0] + __builtin_amdgcn_exp2f(sink2 - mx));
    if (do_store) {
        bf16_t* Op = T.MIX + orow * 1024 + head * 64 + 4 * hi;
#pragma unroll
        for (int dt = 0; dt < 2; ++dt)
#pragma unroll
            for (int i = 0; i < 4; ++i) { u32x2 w; w.x = cvtpk(o[dt][4 * i] * rl, o[dt][4 * i + 1] * rl); w.y = cvtpk(o[dt][4 * i + 2] * rl, o[dt][4 * i + 3] * rl);
                *(u32x2*)(Op + 32 * dt + 8 * i) = w; }
    }
}

__device__ __forceinline__ void unit(const Tensors& T, ATT_LAS unsigned char* lds, bool sample, int blk, int kvh) {
    const int tid = threadIdx.x, lane = tid & 63, wid = __builtin_amdgcn_readfirstlane(tid >> 6), r32 = lane & 31, hi = lane >> 5;
    const int R0 = sample ? (MP + blk * 4) : blk * 128;
    const bool prev_valid = sample ? true : ((blk & 63) != 0);
    const int curN = sample ? 4 : 128;
    const bf16_t* prevK = sample ? T.CK + (size_t)blk * 128 * 128 : T.Kb + (size_t)(R0 - 128) * 128;
    const bf16_t* prevV = sample ? T.CV + (size_t)blk * 128 * 128 : T.Vb + (size_t)(R0 - 128) * 128;
    const bf16_t* curK = T.Kb + (size_t)R0 * 128; const bf16_t* curV = T.Vb + (size_t)R0 * 128;
    u32x4 kv[4], vv[4];
#pragma unroll
    for (int i = 0; i < 4; ++i) {
        const int c = tid + 512 * i, key = c >> 3, ch = c & 7;
        kv[i] = (u32x4){0u, 0u, 0u, 0u}; vv[i] = (u32x4){0u, 0u, 0u, 0u};
        if (key < 128) { if (prev_valid) { kv[i] = *(const u32x4*)(prevK + (size_t)key * 128 + kvh * 64 + ch * 8); vv[i] = *(const u32x4*)(prevV + (size_t)key * 128 + kvh * 64 + ch * 8); } }
        else { int kr = key - 128; kr = kr < curN ? kr : curN - 1; kv[i] = *(const u32x4*)(curK + (size_t)kr * 128 + kvh * 64 + ch * 8); vv[i] = *(const u32x4*)(curV + (size_t)kr * 128 + kvh * 64 + ch * 8); }
    }
    const int nwu = sample ? 4 : 16;
    const int ql = sample ? (r32 < 4 ? r32 : 3) : r32;
    bf16x8 qf[4], qn[4];
    { const int wu = wid < nwu ? wid : 0, hq = wu & 3, g = sample ? 0 : (wu >> 2);
      const bf16_t* Qp = T.Q + (size_t)(R0 + 32 * g + ql) * 512 + (kvh * 4 + hq) * 64 + hi * 8;
#pragma unroll
      for (int ks = 0; ks < 4; ++ks) qf[ks] = *(const bf16x8*)(Qp + ks * 16); }
    {
        const int cc = tid & 31, c0 = 256 * kvh + 8 * cc, rg = tid >> 5;
        float w0[8], w1[8], w2[8];
#pragma unroll
        for (int e = 0; e < 8; ++e) { w0[e] = T.wconv[c0 + e]; w1[e] = T.wconv[512 + c0 + e]; w2[e] = T.wconv[1024 + c0 + e]; }
#define ldu(row, u) do { const u32x4 w_ = *(const u32x4*)(T.Ub + (size_t)(row) * 512 + c0); \
            u[0] = bf_lo(w_.x); u[1] = bf_hi(w_.x); u[2] = bf_lo(w_.y); u[3] = bf_hi(w_.y); u[4] = bf_lo(w_.z); u[5] = bf_hi(w_.z); u[6] = bf_lo(w_.w); u[7] = bf_hi(w_.w); } while (0)
        if (!sample) {
            const int ra = R0 + 8 * rg;
            const bool seq_start = ((blk & 63) == 0) && (rg == 0);
            u32x4 uw[10], gw[8];
#pragma unroll
            for (int j = 0; j < 10; ++j) uw[j] = (j < 2 && seq_start) ? (u32x4){0u, 0u, 0u, 0u} : *(const u32x4*)(T.Ub + (size_t)(ra - 2 + j) * 512 + c0);
#pragma unroll
            for (int j = 0; j < 8; ++j) gw[j] = *(const u32x4*)(T.Gb + (size_t)(ra + j) * 512 + c0);
#pragma unroll
            for (int j = 0; j < 8; ++j) {
                const float um2[8] = {bf_lo(uw[j].x), bf_hi(uw[j].x), bf_lo(uw[j].y), bf_hi(uw[j].y), bf_lo(uw[j].z), bf_hi(uw[j].z), bf_lo(uw[j].w), bf_hi(uw[j].w)};
                const float um1[8] = {bf_lo(uw[j + 1].x), bf_hi(uw[j + 1].x), bf_lo(uw[j + 1].y), bf_hi(uw[j + 1].y), bf_lo(uw[j + 1].z), bf_hi(uw[j + 1].z), bf_lo(uw[j + 1].w), bf_hi(uw[j + 1].w)};
                const float u0[8] = {bf_lo(uw[j + 2].x), bf_hi(uw[j + 2].x), bf_lo(uw[j + 2].y), bf_hi(uw[j + 2].y), bf_lo(uw[j + 2].z), bf_hi(uw[j + 2].z), bf_lo(uw[j + 2].w), bf_hi(uw[j + 2].w)};
                const float gb[8] = {bf_lo(gw[j].x), bf_hi(gw[j].x), bf_lo(gw[j].y), bf_hi(gw[j].y), bf_lo(gw[j].z), bf_hi(gw[j].z), bf_lo(gw[j].w), bf_hi(gw[j].w)};
                float y[8];
#pragma unroll
                for (int e = 0; e < 8; ++e) y[e] = gb[e] * (w0[e] * um2[e] + w1[e] * um1[e] + w2[e] * u0[e]);
                u32x4 w; w.x = cvtpk(y[0], y[1]); w.y = cvtpk(y[2], y[3]); w.z = cvtpk(y[4], y[5]); w.w = cvtpk(y[6], y[7]);
                *(u32x4*)(T.MIX + (size_t)(ra + j) * 1024 + 512 + c0) = w;
            }
        } else if (rg < 4) {
            const int row = R0 + rg;
            float ua[3][8];
#pragma unroll
            for (int k = 0; k < 3; ++k) { const int ss = rg - 2 + k;
                if (ss >= 0) ldu(R0 + ss, ua[k]);
                else { const float* sp = T.sconv + (size_t)(blk * 2 + (ss + 2)) * 512 + c0;
#pragma unroll
                    for (int e = 0; e < 8; ++e) ua[k][e] = sp[e]; } }
            const u32x4 gw = *(const u32x4*)(T.Gb + (size_t)row * 512 + c0);
            const float gb[8] = {bf_lo(gw.x), bf_hi(gw.x), bf_lo(gw.y), bf_hi(gw.y), bf_lo(gw.z), bf_hi(gw.z), bf_lo(gw.w), bf_hi(gw.w)};
            float y[8];
#pragma unroll
            for (int e = 0; e < 8; ++e) y[e] = gb[e] * (w0[e] * ua[0][e] + w1[e] * ua[1][e] + w2[e] * ua[2][e]);
            u32x4 w; w.x = cvtpk(y[0], y[1]); w.y = cvtpk(y[2], y[3]); w.z = cvtpk(y[4], y[5]); w.w = cvtpk(y[6], y[7]);
            *(u32x4*)(T.MIX + (size_t)row * 1024 + 512 + c0) = w;
        }
    }
#undef ldu
#pragma unroll
    for (int i = 0; i < 4; ++i) {
        const int c = tid + 512 * i, key = c >> 3, ch = c & 7;
        *(ATT_LAS u32x4*)(lds + L_K + ch * KCH + key * 16) = kv[i];
        *(ATT_LAS u32x4*)(lds + L_V + (ch >> 2) * VDH + key * 64 + (ch & 3) * 16) = vv[i];
    }
    __syncthreads();
    for (int wu = wid; wu < nwu; wu += 8) {
        const int hq = wu & 3, g = sample ? 0 : (wu >> 2), head = kvh * 4 + hq;
        if (wu + 8 < nwu) { const int g2 = (wu + 8) >> 2; const bf16_t* Qp = T.Q + (size_t)(R0 + 32 * g2 + ql) * 512 + head * 64 + hi * 8;
#pragma unroll
            for (int ks = 0; ks < 4; ++ks) qn[ks] = *(const bf16x8*)(Qp + ks * 16); }
        const bool do_store = !sample || r32 < 4; const size_t orow = (size_t)(R0 + 32 * g + ql);
        if (prev_valid) wave_unit<true>(T, lds, qf, g, head, ql, r32, hi, lane, do_store, orow);
        else            wave_unit<false>(T, lds, qf, g, head, ql, r32, hi, lane, do_store, orow);
#pragma unroll
        for (int ks = 0; ks < 4; ++ks) qf[ks] = qn[ks];
    }
    __syncthreads();
}
}

constexpr int NWAVES = 8;
#ifndef MK_N_LAUNCHES
#define MK_N_LAUNCHES 1
#endif
constexpr int NPHASE = 9;
constexpr int N_LAUNCHES = MK_N_LAUNCHES;
static_assert(N_LAUNCHES == 1 || N_LAUNCHES == NPHASE, "MK_N_LAUNCHES is 1 or 9");

constexpr size_t MiB = 1u << 20;
constexpr size_t WS_CTL = 0, CTL_ZERO_BYTES = 64 * 1024;
constexpr size_t WS_W1GU = 2 * MiB, WS_W1D = 13 * MiB, WS_WIN = 19 * MiB, WS_WOUT = 24 * MiB, WS_W2GU = 26 * MiB, WS_W2D = 37 * MiB, WS_WPG = 43 * MiB, WS_WPP = 45 * MiB;
constexpr size_t STATS_BYTES = (size_t)M * 16 * 4;
constexpr size_t WS_STATS = 46 * MiB;
constexpr size_t WS_RS0 = WS_STATS + 3 * STATS_BYTES;
constexpr size_t WS_CK = 50 * MiB, WS_CV = 54 * MiB;
constexpr size_t WS_PEB = 58 * MiB;
constexpr size_t WS_XB = 67 * MiB;
constexpr size_t WS_KB = 100 * MiB, WS_VB = 105 * MiB;
constexpr size_t WS_PP = 110 * MiB;
constexpr size_t WS_ACT = 143 * MiB;
constexpr size_t WS_QB = 143 * MiB, WS_GB = WS_QB + (size_t)M * 512 * 2, WS_UB = WS_GB + (size_t)M * 512 * 2, WS_MIX = WS_UB + (size_t)M * 512 * 2;
constexpr size_t WS_END = 234 * MiB;
static_assert(WS_W1GU + (size_t)2 * FF * D * 2 <= WS_W1D && WS_W1D + (size_t)D * FF * 2 <= WS_WIN && WS_WIN + (size_t)NIN * D * 2 <= WS_WOUT && WS_WOUT + (size_t)D * D * 2 <= WS_W2GU
              && WS_W2GU + (size_t)2 * FF * D * 2 <= WS_W2D && WS_W2D + (size_t)D * FF * 2 <= WS_WPG && WS_WPG + (size_t)D * D * 2 <= WS_WPP && WS_WPP + (size_t)D * DPLE * 2 <= WS_STATS
              && WS_RS0 + (size_t)M * 4 <= WS_CK && WS_PEB + (size_t)M * DPLE * 2 <= WS_XB && WS_XB + (size_t)M * D * 2 <= WS_KB && WS_KB + (size_t)M * 128 * 2 <= WS_VB
              && WS_VB + (size_t)M * 128 * 2 <= WS_PP && WS_PP + (size_t)M * D * 2 <= WS_ACT && WS_ACT + (size_t)M * FF * 2 <= WS_END && WS_MIX + (size_t)M * D * 2 <= WS_END, "d_ws map");
constexpr int CW_BAR = 4096;
constexpr size_t O_Y = 0, O_KWP = (size_t)M * D, O_VWP = O_KWP + 2 * 128 * 128, O_CVP = O_VWP + 2 * 128 * 128, O_KWS = O_CVP + 2 * 2 * 512, O_VWS = O_KWS + (size_t)128 * 128 * 128,
                 O_CVS = O_VWS + (size_t)128 * 128 * 128, O_END = O_CVS + 128 * 2 * 512;
constexpr int RING_OFF = 0, RING_BYTES = 131072;
constexpr int STAB_OFF = RING_BYTES, STAB_BYTES = 16384;
constexpr int STRIP_BYTES = 4096;
constexpr int LDSCTL_OFF = STAB_OFF + STAB_BYTES + STRIP_BYTES, MISC_OFF = LDSCTL_OFF + 320;
constexpr int LDS_BYTES = 153600;
static_assert(MISC_OFF + 128 <= LDS_BYTES, "LDS map");

struct Args { const float* in[26]; float* out; unsigned char* ws; int ph_lo, ph_hi, li, pad; };
typedef const __attribute__((address_space(4))) Args* KArgs;
__device__ __forceinline__ KArgs kargs() { KArgs p = (KArgs)__builtin_amdgcn_kernarg_segment_ptr(); asm volatile("" : "+s"(p)); return p; }
struct Frame {
    LAS unsigned char* lds;
    volatile LAS unsigned* MISC;
    gu32* ctl;
    int wave;
    int vcu, G;
};

__device__ __forceinline__ float wave_sum(float v) {
#pragma unroll
    for (int o = 1; o < 64; o <<= 1) v += __shfl_xor(v, o);
    return v;
}
__device__ __forceinline__ int map_swiglu(int n0, int up) { return 256 * (n0 >> 7) + 128 * up + (n0 & 127); }
__device__ __forceinline__ int map_in(int c0) {
    if (c0 < 512) { const int head = c0 >> 6, bj = (c0 >> 5) & 1; return 256 * (head >> 2) + 128 * bj + 32 * (head & 3); }
    if (c0 < 768) { const int t = c0 - 512, hv = t >> 6, bj = (t >> 5) & 1; return 512 + 128 * bj + 32 * hv; }
    if (c0 < 1280) return c0;
    if (c0 < 1792) { const int f = c0 - 1280; return 256 * (5 + (f >> 7)) + (f & 127); }
    { const int f = c0 - 1792; return 256 * (5 + (f >> 7)) + 128 + (f & 127); }
}
__device__ __forceinline__ int map_dst(int mode, int c0) { return mode == 0 ? c0 : mode == 1 ? map_swiglu(c0, 0) : mode == 2 ? map_swiglu(c0, 1) : map_in(c0); }
__device__ __forceinline__ void p0_transpose_item(const float* W, int N, const float* gain, bf16* WT, int KT, int mode, LAS unsigned* T, int k0, int n0, int lane) {
    const int a = lane & 15, b = lane >> 4;
    const float* src = W + (size_t)(k0 + 2 * b) * N + n0 + 4 * a;
    f32x4 va[8], vb[8];
#pragma unroll
    for (int j = 0; j < 8; ++j) { va[j] = *(const GAS f32x4*)(src + (size_t)(8 * j) * N); vb[j] = *(const GAS f32x4*)(src + (size_t)(8 * j + 1) * N); }
    const float wsc = mode == 1 ? LOG2E : mode == 2 ? (1.0f / LOG2E) : 1.0f;
#pragma unroll
    for (int j = 0; j < 8; ++j) { float ga = wsc, gb = wsc; if (gain) { ga = gain[k0 + 8 * j + 2 * b] * wsc; gb = gain[k0 + 8 * j + 2 * b + 1] * wsc; }
#pragma unroll
        for (int e = 0; e < 4; ++e) T[(4 * a + e) * 33 + 4 * j + b] = pk2(va[j][e] * ga, vb[j][e] * gb); }
    LDS_WAIT(); asm volatile("" ::: "memory");
#pragma unroll
    for (int jj = 0; jj < 8; ++jj) { const int n = 8 * jj + (lane >> 3), kc = lane & 7; const LAS unsigned* s = T + n * 33 + 4 * kc;
        v4u o; o.x = s[0]; o.y = s[1]; o.z = s[2]; o.w = s[3];
        const int drow = map_dst(mode, n0 + (n & 32)) + (n & 31);
        *(GAS v4u*)(WT + (size_t)drow * KT + k0 + 8 * kc) = o; }
    LDS_WAIT(); asm volatile("" ::: "memory");
}
__device__ __forceinline__ void p0_weights(Frame& F, KArgs Ap, int which, int gw, int NGW) {
    int tid_ = threadIdx.x; asm volatile("" : "+v"(tid_)); const int lane = tid_ & 63;
    unsigned char* ws = Ap->ws;
    LAS unsigned* scr = (LAS unsigned*)(F.lds + RING_OFF + F.wave * 16384);
    constexpr int I_GU = (D / 64) * (FF / 64), I_DN = (FF / 64) * (D / 64), I_IN = (D / 64) * (NIN / 64), I_SQ = (D / 64) * (D / 64), I_PP = (DPLE / 64) * (D / 64);
    constexpr int NITEMS = 4 * I_GU + 2 * I_DN + I_IN + 2 * I_SQ + I_PP;
    constexpr int B1 = 2 * I_GU, B3 = B1 + I_DN + I_IN + I_SQ + 2 * I_GU, B4 = B3 + I_DN + I_SQ;
    const int lo_ = which == 1 ? B1 : B3, n_ = which == 0 ? B1 + I_PP : which == 1 ? B3 - B1 : B4 - B3;
    for (int it0 = gw; it0 < n_; it0 += NGW) {
        int r = which == 0 ? (it0 < B1 ? it0 : it0 - B1 + B4) : lo_ + it0;
        const float* W; const float* gain = nullptr; bf16* WT; int K, N, mode;
        if (r < I_GU) { W = Ap->in[9]; WT = (bf16*)(ws + WS_W1GU); K = D; N = FF; mode = 1; }
        else if ((r -= I_GU) < I_GU) { W = Ap->in[10]; WT = (bf16*)(ws + WS_W1GU); K = D; N = FF; mode = 2; }
        else if ((r -= I_GU) < I_DN) { W = Ap->in[11]; WT = (bf16*)(ws + WS_W1D); K = FF; N = D; mode = 0; }
        else if ((r -= I_DN) < I_IN) { W = Ap->in[13]; gain = Ap->in[12]; WT = (bf16*)(ws + WS_WIN); K = D; N = NIN; mode = 3; }
        else if ((r -= I_IN) < I_SQ) { W = Ap->in[18]; WT = (bf16*)(ws + WS_WOUT); K = D; N = D; mode = 0; }
        else if ((r -= I_SQ) < I_GU) { W = Ap->in[20]; gain = Ap->in[19]; WT = (bf16*)(ws + WS_W2GU); K = D; N = FF; mode = 1; }
        else if ((r -= I_GU) < I_GU) { W = Ap->in[21]; gain = Ap->in[19]; WT = (bf16*)(ws + WS_W2GU); K = D; N = FF; mode = 2; }
        else if ((r -= I_GU) < I_DN) { W = Ap->in[22]; WT = (bf16*)(ws + WS_W2D); K = FF; N = D; mode = 0; }
        else if ((r -= I_DN) < I_SQ) { W = Ap->in[24]; gain = Ap->in[23]; WT = (bf16*)(ws + WS_WPG); K = D; N = D; mode = 0; }
        else { r -= I_SQ; W = Ap->in[25]; WT = (bf16*)(ws + WS_WPP); K = DPLE; N = D; mode = 0; }
        const int nblk = N / 64, kb = r / nblk, nb = r % nblk, k0 = 64 * kb, n0 = 64 * nb;
        p0_transpose_item(W, N, gain, WT, K, mode, scr, k0, n0, lane);
    }
}
__device__ __forceinline__ void p0_prologue(Frame& F, KArgs Ap) {
    const int tid0 = (int)threadIdx.x, lane0 = tid0 & 63;
    unsigned char* ws = Ap->ws;
    const int gw = F.vcu * NWAVES + F.wave, NGW = F.G * NWAVES;
    p0_weights(F, Ap, 0, gw, NGW);
    {
        const float* g1 = Ap->in[8]; bf16* XB = (bf16*)(ws + WS_XB);
        f32x4 gv[4];
#pragma unroll
        for (int j = 0; j < 4; ++j) gv[j] = ((const GAS f32x4*)g1)[64 * j + lane0];
        for (int m0 = gw; m0 < M; m0 += 2 * NGW) {
            f32x4 v[2][4];
#pragma unroll
            for (int q = 0; q < 2; ++q) { const int m = m0 + q * NGW; if (m < M) { const float* xrow = (m < MP) ? Ap->in[0] + (size_t)m * D : Ap->in[1] + (size_t)(m - MP) * D;
                const GAS f32x4* xr = (const GAS f32x4*)xrow + lane0;
#pragma unroll
                for (int j = 0; j < 4; ++j) v[q][j] = xr[64 * j]; } }
#pragma unroll
            for (int q = 0; q < 2; ++q) { const int m = m0 + q * NGW; if (m < M) { float s = 0.f;
#pragma unroll
                for (int j = 0; j < 4; ++j) s += (v[q][j].x * v[q][j].x + v[q][j].y * v[q][j].y) + (v[q][j].z * v[q][j].z + v[q][j].w * v[q][j].w);
                const float rms = sqrtf(wave_sum(s) * (1.f / D) + RMS_EPS), rstd = 1.f / rms;
                if (lane0 == 0) ((float*)(ws + WS_RS0))[m] = rms;
                GAS unsigned long long* o8 = (GAS unsigned long long*)(XB + (size_t)m * D) + lane0;
#pragma unroll
                for (int j = 0; j < 4; ++j) { const f32x4 o = v[q][j] * rstd * gv[j]; o8[64 * j] = (unsigned long long)pk2(o.x, o.y) | ((unsigned long long)pk2(o.z, o.w) << 32); } } }
        }
    }
    {
        const int gt = F.vcu * (NWAVES * 64) + tid0, NT = F.G * NWAVES * 64;
        for (int i = gt; i < 3 * MS * 16; i += NT) { const int k = i / (MS * 16), j = i - k * (MS * 16); ((float*)(ws + WS_STATS + (size_t)k * STATS_BYTES))[(size_t)MP * 16 + j] = 0.f; }
        bf16* PEB = (bf16*)(ws + WS_PEB);
        constexpr int NPE = M * DPLE / 8, NPEP = MP * DPLE / 8;
        for (int i = gt; i < NPE; i += NT) {
            const float* src = (i < NPEP) ? Ap->in[2] + (size_t)i * 8 : Ap->in[3] + (size_t)(i - NPEP) * 8;
            const f32x4 a = *(const GAS f32x4*)src, b = *(const GAS f32x4*)(src + 4);
            v4u o; o.x = pk2(a.x, a.y); o.y = pk2(a.z, a.w); o.z = pk2(b.x, b.y); o.w = pk2(b.z, b.w);
            *(GAS v4u*)(PEB + (size_t)i * 8) = o;
        }
        constexpr int NC = 128 * 128 * 128 / 8;
        for (int i = gt; i < 2 * NC; i += NT) {
            const int which = i >= NC, j = which ? i - NC : i;
            const float* src = Ap->in[4 + which] + (size_t)j * 8;
            const f32x4 a = *(const GAS f32x4*)src, b = *(const GAS f32x4*)(src + 4);
            v4u o; o.x = pk2(a.x, a.y); o.y = pk2(a.z, a.w); o.z = pk2(b.x, b.y); o.w = pk2(b.z, b.w);
            *(GAS v4u*)((bf16*)(ws + (which ? WS_CV : WS_CK)) + (size_t)j * 8) = o;
            const int w = (j >> 4) & 127;
            if (w >= 4) { float* dst = Ap->out + (which ? O_VWS : O_KWS) + (size_t)j * 8 - 512; *(GAS f32x4*)dst = a; *(GAS f32x4*)(dst + 4) = b; }
        }
    }
}

__constant__ unsigned char c_bucket[128] = {0, 1, 2, 3, 4, 5, 6, 7, 8, 9, 10, 11, 12, 13, 14, 15, 16, 16, 16, 17, 17, 18, 18, 18, 19, 19, 19, 20, 20, 20, 20, 21, 21, 21, 21, 22, 22, 22, 22, 22, 23, 23, 23, 23, 23, 23, 24, 24, 24, 24, 24, 24,
    25, 25, 25, 25, 25, 25, 25, 26, 26, 26, 26, 26, 26, 26, 26, 27, 27, 27, 27, 27, 27, 27, 27, 27, 27, 28, 28, 28, 28, 28, 28, 28, 28, 28, 28, 29, 29, 29, 29, 29, 29, 29, 29, 29, 29, 29, 29, 30, 30, 30, 30, 30, 30, 30, 30, 30, 30, 30, 30, 30, 30,
    31, 31, 31, 31, 31, 31, 31, 31, 31, 31, 31, 31, 31, 31, 31};

__global__ void __launch_bounds__(NWAVES * 64, 2) mk_fwd(Args args) {
    extern __shared__ __attribute__((aligned(16))) unsigned char lds[];
    Frame F;
    F.lds = (LAS unsigned char*)lds;
    F.MISC = (volatile LAS unsigned*)(F.lds + MISC_OFF);
    F.wave = __builtin_amdgcn_readfirstlane((int)threadIdx.x >> 6);
    F.G = gridDim.x; { const int bx = blockIdx.x; F.vcu = (F.G % 8 == 0) ? (bx % 8) * (F.G / 8) + bx / 8 : bx; }
    F.ctl = (gu32*)(args.ws + WS_CTL);
    for (int u = (int)threadIdx.x; u < (LDS_BYTES - LDSCTL_OFF) / 4; u += NWAVES * 64) ((LAS unsigned*)(F.lds + LDSCTL_OFF))[u] = 0u;
    __syncthreads();
    XcdBarrier bar; bar.bar = (unsigned*)(F.ctl + CW_BAR); bar.x = 0; bar.st = nullptr;
    if (N_LAUNCHES == 1) bar = xcd_barrier_post((unsigned*)(F.ctl + CW_BAR), F.MISC + 8);
#define GRID_BAR() do { if (N_LAUNCHES == 1) xcd_barrier(bar); } while (0)
    const int lo = args.ph_lo, hi = args.ph_hi;
#define IN(k) (lo <= (k) && (k) < hi)
#define BOTH(k) (IN(k) && IN((k) + 1))
#define PHASE_ARGS() KArgs KA = kargs(); unsigned char* const ws = KA->ws; float* const out = KA->out; (void)out; \
    bf16* const XB = (bf16*)(ws + WS_XB); bf16* const ACT = (bf16*)(ws + WS_ACT); bf16* const PP = (bf16*)(ws + WS_PP); (void)XB; (void)ACT; (void)PP; \
    float* const ST1 = (float*)(ws + WS_STATS); float* const ST2 = (float*)(ws + WS_STATS + STATS_BYTES); float* const ST3 = (float*)(ws + WS_STATS + 2 * STATS_BYTES); (void)ST1; (void)ST2; (void)ST3

    if (IN(0)) { p0_prologue(F, kargs()); if (BOTH(0)) GRID_BAR(); }

    if (IN(1)) { PHASE_ARGS();
        { pg8::Gemm g{XB, (const bf16*)(ws + WS_W1GU), M, 2 * FF, D}; pg8::StaticOrder S; S.init(M, 2 * FF, F.G, (int)blockIdx.x);
          pg8::EpiSwiglu<false> E{ACT, nullptr, nullptr};
          pg8::gemm_phase<pg8::EpiSwiglu<false>, pg8::StaticOrder, true, true>(F.lds + RING_OFF, g, S, E); }
        { constexpr int NU = (M / 256) * (2 * FF / 256), FIRST_IDLE = NU % 256;
          if (F.G == 256 && (int)blockIdx.x >= FIRST_IDLE) p0_weights(F, KA, 1, ((int)blockIdx.x - FIRST_IDLE) * NWAVES + F.wave, (256 - FIRST_IDLE) * NWAVES);
          else if (F.G != 256) p0_weights(F, KA, 1, F.vcu * NWAVES + F.wave, F.G * NWAVES); }
        if (BOTH(1)) GRID_BAR();
    }
    if (IN(2)) { PHASE_ARGS();
        pg8::Gemm g{ACT, (const bf16*)(ws + WS_W1D), MP, D, FF}; pg8::StaticOrder S; S.init(MP, D, F.G, (int)blockIdx.x);
        pg8::EpiResid<true> E{(const float*)(ws + WS_RS0), KA->in[8], XB, ST1, 0.5f};
        pg8::gemm_phase<pg8::EpiResid<true>, pg8::StaticOrder, true, true>(F.lds + RING_OFF, g, S, E);
        if (BOTH(2)) GRID_BAR();
    }
    if (IN(3)) { PHASE_ARGS();
        { pg8::Gemm g{XB, (const bf16*)(ws + WS_WIN), M, NIN, D}; pg8::StaticOrder S; S.init(M, NIN, F.G, (int)blockIdx.x);
        pg8::EpiIn E{ST1, F.lds + STAB_OFF, KA->in[14], KA->in[15], (bf16*)(ws + WS_QB), (bf16*)(ws + WS_KB), (bf16*)(ws + WS_VB), (bf16*)(ws + WS_GB), (bf16*)(ws + WS_UB),
                     out + O_KWP, out + O_VWP, out + O_CVP, out + O_KWS, out + O_VWS, out + O_CVS};
        pg8::gemm_phase<pg8::EpiIn, pg8::StaticOrder, true, true>(F.lds + RING_OFF, g, S, E); }
        { int kpp = DPLE; asm volatile("" : "+s"(kpp));
          pg8::Gemm g{(const bf16*)(ws + WS_PEB), (const bf16*)(ws + WS_WPP), M, D, kpp}; pg8::StaticOrder S; if (F.G == 256) { const int j = (int)blockIdx.x - 82; S.init(M, D, 174, j >= 0 ? j : (1 << 20)); } else S.init(M, D, F.G, (int)blockIdx.x);
          pg8::EpiStoreBf16 E{PP, D};
          pg8::gemm_phase<pg8::EpiStoreBf16, pg8::StaticOrder, true, true>(F.lds + RING_OFF, g, S, E); }
        if (BOTH(3)) GRID_BAR();
    }
    if (IN(4)) { PHASE_ARGS();
        { LAS float* bt = (LAS float*)(F.lds + att::L_BIAS); const float* relb = KA->in[7];
          for (int i = (int)threadIdx.x; i < 8 * att::BIASW; i += NWAVES * 64) { const int h = i / att::BIASW, d = i - h * att::BIASW - 32; bt[i] = (d >= 0 && d < 128) ? relb[c_bucket[d] * 8 + h] * LOG2E : 0.f; } }
        const att::Tensors T{(const bf16*)(ws + WS_QB), (const bf16*)(ws + WS_KB), (const bf16*)(ws + WS_VB), (const bf16*)(ws + WS_GB), (const bf16*)(ws + WS_UB), (const bf16*)(ws + WS_CK), (const bf16*)(ws + WS_CV),
                             (bf16*)(ws + WS_MIX), KA->in[17], KA->in[6], KA->in[16], KA->in[7]};
        for (int i = blockIdx.x; i < 512; i += F.G) { const bool sample = i >= 256; const int j = i & 255; att::unit(T, F.lds, sample, j >> 1, j & 1); }
        if (BOTH(4)) GRID_BAR();
    }
    if (IN(5)) { PHASE_ARGS();
        pg8::Gemm g{(const bf16*)(ws + WS_MIX), (const bf16*)(ws + WS_WOUT), MP, D, D}; pg8::StaticOrder S; S.init(MP, D, F.G, (int)blockIdx.x);
        pg8::EpiResid<false> E{nullptr, nullptr, XB, ST2, 1.0f};
        pg8::gemm_phase<pg8::EpiResid<false>, pg8::StaticOrder, true, true>(F.lds + RING_OFF, g, S, E);
        if (BOTH(5)) GRID_BAR();
    }
    if (IN(6)) { PHASE_ARGS();
        pg8::Gemm g{XB, (const bf16*)(ws + WS_W2GU), M, 2 * FF, D}; pg8::StaticOrder S; S.init(M, 2 * FF, F.G, (int)blockIdx.x);
        pg8::EpiSwiglu<true> E{ACT, ST2, F.lds + STAB_OFF};
        pg8::gemm_phase<pg8::EpiSwiglu<true>, pg8::StaticOrder, true, true>(F.lds + RING_OFF, g, S, E);
        if (F.G == 256 && (int)blockIdx.x >= 172) p0_weights(F, KA, 2, ((int)blockIdx.x - 172) * NWAVES + F.wave, 84 * NWAVES);
        else if (F.G != 256) p0_weights(F, KA, 2, F.vcu * NWAVES + F.wave, F.G * NWAVES);
        if (BOTH(6)) GRID_BAR();
    }
    if (IN(7)) { PHASE_ARGS();
        pg8::Gemm g{ACT, (const bf16*)(ws + WS_W2D), MP, D, FF}; pg8::StaticOrder S; S.init(MP, D, F.G, (int)blockIdx.x);
        pg8::EpiResid<false> E{nullptr, nullptr, XB, ST3, 0.5f};
        pg8::gemm_phase<pg8::EpiResid<false>, pg8::StaticOrder, true, true>(F.lds + RING_OFF, g, S, E);
        if (BOTH(7)) GRID_BAR();
    }
    if (IN(8)) { PHASE_ARGS();
        pg8::Gemm g{XB, (const bf16*)(ws + WS_WPG), MP, D, D}; pg8::StaticOrder S; S.init(MP, D, F.G, (int)blockIdx.x);
        pg8::EpiPle E{ST3, F.lds + STAB_OFF, PP, XB, out};
        pg8::gemm_phase<pg8::EpiPle, pg8::StaticOrder, true, true>(F.lds + RING_OFF, g, S, E);
    }
#undef IN
#undef BOTH
#undef GRID_BAR
#undef PHASE_ARGS
}

extern "C" void kernel_launch(void* const* d_in, const int* in_sizes, int n_in, void* d_out, int out_size, void* d_ws, size_t ws_size, hipStream_t stream) {
    static int grid = 0;
    if (grid == 0) {
        if (n_in != 26 || in_sizes[0] != MP * D || (size_t)out_size != O_END || ws_size < WS_END) { fprintf(stderr, "kernel_launch: unexpected shapes: n_in %d, in0 %d, out %d, ws %zu; nothing launched\n", n_in, n_in > 0 ? in_sizes[0] : -1, out_size, ws_size); grid = -1; return; }
        int dev = 0, cus = 0, per_cu = 0;
        if (hipGetDevice(&dev) != hipSuccess || hipDeviceGetAttribute(&cus, hipDeviceAttributeMultiprocessorCount, dev) != hipSuccess) { fprintf(stderr, "kernel_launch: hipGetDevice / hipDeviceGetAttribute failed\n"); grid = -1; return; }
        if (hipFuncSetAttribute((const void*)mk_fwd, hipFuncAttributeMaxDynamicSharedMemorySize, LDS_BYTES) != hipSuccess) { fprintf(stderr, "kernel_launch: hipFuncSetAttribute failed\n"); grid = -1; return; }
        if (hipOccupancyMaxActiveBlocksPerMultiprocessor(&per_cu, (const void*)mk_fwd, NWAVES * 64, LDS_BYTES) != hipSuccess || per_cu < 1)
            fprintf(stderr, "kernel_launch: note: the occupancy query reports %d workgroups per CU\n", per_cu);
        (void)hipGetLastError();
        grid = cus;
    }
    if (grid < 0) return;
    if (hipMemsetAsync((char*)d_ws + WS_CTL, 0, CTL_ZERO_BYTES, stream) != hipSuccess) { fprintf(stderr, "kernel_launch: hipMemsetAsync failed\n"); return; }
    Args a{};
    for (int i = 0; i < 26; ++i) a.in[i] = (const float*)d_in[i];
    a.out = (float*)d_out; a.ws = (unsigned char*)d_ws;
    for (int li = 0; li < N_LAUNCHES; ++li) {
        a.ph_lo = (N_LAUNCHES == 1) ? 0 : li; a.ph_hi = (N_LAUNCHES == 1) ? NPHASE : li + 1; a.li = li;
        hipLaunchKernelGGL(mk_fwd, dim3(grid), dim3(NWAVES * 64), LDS_BYTES, stream, a);
        const hipError_t le = hipPeekAtLastError();
        if (le != hipSuccess) { fprintf(stderr, "kernel_launch: launch %d failed: %s\n", li, hipGetErrorName(le)); break; }
    }
}
```

```cpp
#include <hip/hip_runtime.h>
#include <cstdio>
#include <cstdint>

constexpr int D = 1024, FF = 2816, NIN = 2304, DPLE = 256;
constexpr int SEQ = 8192, MP = 2 * SEQ, MS = 128 * 4, M = MP + MS;
constexpr float RMS_EPS = 1e-6f;
constexpr float LOG2E = 1.4426950408889634f;
constexpr float QSCALE = 0.125f * LOG2E;
__device__ __forceinline__ float bf_lo(unsigned w) { return __uint_as_float(w << 16); }
__device__ __forceinline__ float bf_hi(unsigned w) { return __uint_as_float(w & 0xffff0000u); }
#define MK_N_LAUNCHES 1
namespace pg8 {
#define PG8_LAS __attribute__((address_space(3)))
typedef unsigned short bf16_t;
typedef short bf16x8 __attribute__((ext_vector_type(8)));
typedef float f32x4 __attribute__((ext_vector_type(4)));
typedef unsigned u32x4 __attribute__((ext_vector_type(4)));
constexpr int BM = 256, BK = 64, HALF = 128, HTB = HALF * BK * 2  , STAGE_BYTES = 8 * HTB, NXCD = 8, WGM = 8;

__host__ __device__ __forceinline__ int lds_byte(int r, int c) { const int st = (r >> 4) * 2 + (c >> 5), rr = r & 15, cc = c & 31, ob = rr * 64 + cc * 2; return st * 1024 + (ob ^ (((ob >> 9) & 1) << 5)); }
__host__ __device__ __forceinline__ void stage_rc(int b, int& R, int& C) { const int st = b / 1024, sb = b % 1024, swz = sb ^ (((sb >> 9) & 1) << 5); R = (st >> 1) * 16 + swz / 64; C = (st & 1) * 32 + (swz % 64) / 2; }
__host__ __device__ __forceinline__ int perm32(int rho) { const int n = rho >> 4, i = rho & 15; return 8 * (i >> 2) + 4 * n + (i & 3); }

struct Unit { int pm, pn; };
struct Gemm { const bf16_t* A; const bf16_t* Bt; int M, N, K; };

struct StaticOrder {
    int nM, nN, nwg, G, c;
    __host__ __device__ void init(int M, int N, int G_, int c_) { nM = M / BM; nN = N / BM; nwg = nM * nN; G = G_; c = c_; }
    __host__ __device__ bool next(int i, Unit& u) const {
        const long L = (long)i * G + c; if (L >= nwg) return false;
        int wgid = (int)L; { const int q = nwg / NXCD, r = nwg % NXCD, xcd = wgid % NXCD, off = wgid / NXCD; wgid = (xcd < r ? xcd * (q + 1) : r * (q + 1) + (xcd - r) * q) + off; }
        const int nig = WGM * nN, gid = wgid / nig, fm = gid * WGM, gsz = (nM - fm) < WGM ? (nM - fm) : WGM;
        u.pm = fm + ((wgid % nig) % gsz); u.pn = (wgid % nig) / gsz; return true;
    }
    __device__ __forceinline__ void a_ready(const Unit&) const {}
    __device__ __forceinline__ void done(const Unit&) const {}
};

__device__ __forceinline__ unsigned cvt_pk_bf16(float lo, float hi) { unsigned r; asm volatile("v_cvt_pk_bf16_f32 %0, %1, %2" : "=v"(r) : "v"(lo), "v"(hi)); return r; }
typedef float f32x2 __attribute__((ext_vector_type(2)));
__device__ __forceinline__ float row_rscale(const float* stats, int row) {
    const f32x4* p = (const f32x4*)(stats + (size_t)row * 16);
    const f32x4 a = p[0], b = p[1], c = p[2], d = p[3];
    const f32x4 s = (a + b) + (c + d);
    const float t = (s[0] + s[1]) + (s[2] + s[3]);
    return __builtin_amdgcn_rsqf(t * (1.0f / 1024.0f) + RMS_EPS);
}
__device__ __forceinline__ float row_rscale_lds(const PG8_LAS unsigned char* stab, int rowp, int fq) {
    const f32x4 a = *(const PG8_LAS f32x4*)(stab + rowp * 64 + fq * 16);
    float t = (a[0] + a[1]) + (a[2] + a[3]);
    t += __shfl_xor(t, 16); t += __shfl_xor(t, 32);
    return __builtin_amdgcn_rsqf(t * (1.0f / 1024.0f) + RMS_EPS);
}
__device__ __forceinline__ float row_rscale4(const float* stats, int row, int fq) {
    const f32x4 a = *(const f32x4*)(stats + (size_t)row * 16 + 4 * fq);
    float t = (a[0] + a[1]) + (a[2] + a[3]);
    t += __shfl_xor(t, 16); t += __shfl_xor(t, 32);
    return __builtin_amdgcn_rsqf(t * (1.0f / 1024.0f) + RMS_EPS);
}

struct EpiStoreBf16 {
    static constexpr bool PERM = true, AFTER_DRAIN = false, STATS_LDS = false, STRIP = false;
    bf16_t* O; int ldc;
    __device__ __forceinline__ void operator()(const f32x4 (&acc)[2][2][4][2], const Unit& u, int wr, int wc, int fr, int fq) const {
        const int row0 = u.pm * BM + wr * 64 + fr, col0 = u.pn * BM + wc * 32 + 8 * fq;
#pragma unroll
        for (int ai = 0; ai < 2; ++ai)
#pragma unroll
            for (int m = 0; m < 4; ++m) { bf16_t* rowp = O + (size_t)(row0 + ai * HALF + m * 16) * ldc + col0;
#pragma unroll
                for (int bj = 0; bj < 2; ++bj) { const f32x4 v0 = acc[ai][bj][m][0], v1 = acc[ai][bj][m][1];
                    u32x4 w; w.x = cvt_pk_bf16(v0[0], v0[1]); w.y = cvt_pk_bf16(v0[2], v0[3]); w.z = cvt_pk_bf16(v1[0], v1[1]); w.w = cvt_pk_bf16(v1[2], v1[3]);
                    *(u32x4*)(rowp + bj * HALF) = w; } }
    }
};

template <bool NORM> struct EpiSwiglu {
    static constexpr bool PERM = true, AFTER_DRAIN = false, STATS_LDS = NORM, STRIP = false;
    bf16_t* O; const float* stats; const PG8_LAS unsigned char* stab;
    __device__ __forceinline__ void operator()(const f32x4 (&acc)[2][2][4][2], const Unit& u, int wr, int wc, int fr, int fq) const {
        const int row0 = u.pm * BM + wr * 64 + fr, f0 = u.pn * 128 + wc * 32 + 8 * fq;
#pragma unroll
        for (int ai = 0; ai < 2; ++ai)
#pragma unroll
            for (int m = 0; m < 4; ++m) {
                const int row = row0 + ai * HALF + m * 16;
                float r = 1.0f, rinv = 1.0f; if (NORM) { r = row_rscale_lds(stab, row - u.pm * BM, fq); rinv = __builtin_amdgcn_rcpf(r); }
                float o[8];
#pragma unroll
                for (int n = 0; n < 2; ++n)
#pragma unroll
                    for (int e = 0; e < 4; ++e) { float g = acc[ai][0][m][n][e]; const float up = acc[ai][1][m][n][e];
                        if (NORM) g *= r;
                        const float ex = __builtin_amdgcn_exp2f(-g);
                        const float den = NORM ? __builtin_fmaf(ex, rinv, rinv) : 1.0f + ex;
                        o[n * 4 + e] = g * __builtin_amdgcn_rcpf(den) * up; }
                u32x4 w; w.x = cvt_pk_bf16(o[0], o[1]); w.y = cvt_pk_bf16(o[2], o[3]); w.z = cvt_pk_bf16(o[4], o[5]); w.w = cvt_pk_bf16(o[6], o[7]);
                *(u32x4*)(O + (size_t)row * FF + f0) = w;
            }
    }
};

template <bool FROM_H1> struct EpiResid {
    static constexpr bool PERM = true, AFTER_DRAIN = false, STATS_LDS = false, STRIP = true;
    const float* rms; const float* g;
    bf16_t* xb; float* stats; float alpha;
    __device__ __forceinline__ void strip(const f32x4 (&accS)[2], const Unit& u, int wr, int wc, int fr, int fq) const {
        const int row = MP + 8 * u.pm + fr, col = u.pn * BM + wr * HALF + wc * 32 + 8 * fq;
        float ss = 0.f;
        if (fr < 8) {
            const u32x4 p = *(const u32x4*)(xb + (size_t)row * D + col);
            f32x4 a0 = (f32x4){bf_lo(p.x), bf_hi(p.x), bf_lo(p.y), bf_hi(p.y)}, a1 = (f32x4){bf_lo(p.z), bf_hi(p.z), bf_lo(p.w), bf_hi(p.w)};
            if (FROM_H1) { const float rr = rms[row]; const f32x4 g0 = *(const f32x4*)(g + col), g1 = *(const f32x4*)(g + col + 4);
                a0 = a0 * rr * (f32x4){1.0f / g0[0], 1.0f / g0[1], 1.0f / g0[2], 1.0f / g0[3]}; a1 = a1 * rr * (f32x4){1.0f / g1[0], 1.0f / g1[1], 1.0f / g1[2], 1.0f / g1[3]}; }
            const f32x4 v0 = a0 + accS[0] * alpha, v1 = a1 + accS[1] * alpha;
            u32x4 w; w.x = cvt_pk_bf16(v0[0], v0[1]); w.y = cvt_pk_bf16(v0[2], v0[3]); w.z = cvt_pk_bf16(v1[0], v1[1]); w.w = cvt_pk_bf16(v1[2], v1[3]);
            *(u32x4*)(xb + (size_t)row * D + col) = w;
            ss = (v0[0] * v0[0] + v0[1] * v0[1]) + (v0[2] * v0[2] + v0[3] * v0[3]) + (v1[0] * v1[0] + v1[1] * v1[1]) + (v1[2] * v1[2] + v1[3] * v1[3]);
        }
        ss += __shfl_xor(ss, 16); ss += __shfl_xor(ss, 32);
        if (fr < 8 && fq == 0) atomicAdd(stats + (size_t)row * 16 + u.pn * 4 + wc, ss);
    }
    __device__ __forceinline__ void operator()(const f32x4 (&acc)[2][2][4][2], const Unit& u, int wr, int wc, int fr, int fq) const {
        const int row0 = u.pm * BM + wr * 64 + fr, col0 = u.pn * BM + wc * 32 + 8 * fq;
        f32x4 ig[2][2];
        if (FROM_H1) {
#pragma unroll
            for (int bj = 0; bj < 2; ++bj)
#pragma unroll
                for (int n = 0; n < 2; ++n) { const f32x4 gv = *(const f32x4*)(g + col0 + bj * HALF + 4 * n); ig[bj][n] = (f32x4){1.0f / gv[0], 1.0f / gv[1], 1.0f / gv[2], 1.0f / gv[3]}; } }
#pragma unroll
        for (int ai = 0; ai < 2; ++ai) {
            u32x4 pw[4][2]; float rr[4];
#pragma unroll
            for (int m = 0; m < 4; ++m) { const int row = row0 + ai * HALF + m * 16;
                rr[m] = 1.0f; if (FROM_H1) rr[m] = rms[row];
#pragma unroll
                for (int bj = 0; bj < 2; ++bj) pw[m][bj] = *(const u32x4*)(xb + (size_t)row * D + col0 + bj * HALF); }
#pragma unroll
            for (int m = 0; m < 4; ++m) {
                const int row = row0 + ai * HALF + m * 16;
                float ss = 0.f;
#pragma unroll
                for (int bj = 0; bj < 2; ++bj) { const int c = col0 + bj * HALF; const u32x4 p = pw[m][bj];
                    f32x4 a0 = (f32x4){bf_lo(p.x), bf_hi(p.x), bf_lo(p.y), bf_hi(p.y)}, a1 = (f32x4){bf_lo(p.z), bf_hi(p.z), bf_lo(p.w), bf_hi(p.w)};
                    if (FROM_H1) { a0 = a0 * rr[m] * ig[bj][0]; a1 = a1 * rr[m] * ig[bj][1]; }
                    const f32x4 v0 = a0 + acc[ai][bj][m][0] * alpha, v1 = a1 + acc[ai][bj][m][1] * alpha;
                    u32x4 w; w.x = cvt_pk_bf16(v0[0], v0[1]); w.y = cvt_pk_bf16(v0[2], v0[3]); w.z = cvt_pk_bf16(v1[0], v1[1]); w.w = cvt_pk_bf16(v1[2], v1[3]);
                    *(u32x4*)(xb + (size_t)row * D + c) = w;
                    ss += (v0[0] * v0[0] + v0[1] * v0[1]) + (v0[2] * v0[2] + v0[3] * v0[3]) + (v1[0] * v1[0] + v1[1] * v1[1]) + (v1[2] * v1[2] + v1[3] * v1[3]); }
                ss += __shfl_xor(ss, 16); ss += __shfl_xor(ss, 32);
                if (fq == 0) stats[(size_t)row * 16 + u.pn * 4 + wc] = ss;
            }
        }
    }
};

struct EpiIn {
    static constexpr bool PERM = true, AFTER_DRAIN = false, STATS_LDS = true, STRIP = false;
    const float* stats; const PG8_LAS unsigned char* stab; const float* qn; const float* kn;
    bf16_t *Q, *Kb, *Vb, *Gb, *Ub;
    float *kwinP, *vwinP, *convP, *kwinS, *vwinS, *convS;
    __device__ __forceinline__ void operator()(const f32x4 (&acc)[2][2][4][2], const Unit& u, int wr, int wc, int fr, int fq) const {
        const int row0 = u.pm * BM + wr * 64 + fr, pn = u.pn;
        f32x4 gn[2][2];
        if (pn < 3) { const float* gp = (pn < 2) ? qn : kn;
#pragma unroll
            for (int bj = 0; bj < 2; ++bj)
#pragma unroll
                for (int n = 0; n < 2; ++n) gn[bj][n] = *(const f32x4*)(gp + 32 * bj + 8 * fq + 4 * n); }
#pragma unroll
        for (int ai = 0; ai < 2; ++ai)
#pragma unroll
            for (int m = 0; m < 4; ++m) {
                const int row = row0 + ai * HALF + m * 16;
                const float r = row_rscale_lds(stab, row - u.pm * BM, fq);
                f32x4 z[2][2];
#pragma unroll
                for (int bj = 0; bj < 2; ++bj)
#pragma unroll
                    for (int n = 0; n < 2; ++n) z[bj][n] = acc[ai][bj][m][n] * r;
                if (pn < 3) {
                    const bool isv = (pn == 2 && wc >= 2);
                    if (!isv) {
                        float ss = 0.f;
#pragma unroll
                        for (int bj = 0; bj < 2; ++bj)
#pragma unroll
                            for (int n = 0; n < 2; ++n) ss += (z[bj][n][0] * z[bj][n][0] + z[bj][n][1] * z[bj][n][1]) + (z[bj][n][2] * z[bj][n][2] + z[bj][n][3] * z[bj][n][3]);
                        ss += __shfl_xor(ss, 16); ss += __shfl_xor(ss, 32);
                        float rq = __builtin_amdgcn_rsqf(ss * (1.0f / 64.0f) + RMS_EPS); if (pn < 2) rq *= QSCALE;
#pragma unroll
                        for (int bj = 0; bj < 2; ++bj)
#pragma unroll
                            for (int n = 0; n < 2; ++n) z[bj][n] = z[bj][n] * rq * gn[bj][n];
                    }
                    bf16_t* dst; float* win = nullptr;
                    if (pn < 2) dst = Q + (size_t)row * 512 + (pn * 4 + wc) * 64 + 8 * fq;
                    else { const int kvh = wc & 1; dst = (isv ? Vb : Kb) + (size_t)row * 128 + kvh * 64 + 8 * fq;
                        if (row < MP) { const int t = row & (SEQ - 1); if (t >= SEQ - 128) win = (isv ? vwinP : kwinP) + ((size_t)(((row >> 13) * 128 + (t - (SEQ - 128))) * 2 + kvh)) * 64 + 8 * fq; }
                        else { const int i = row - MP; win = (isv ? vwinS : kwinS) + ((size_t)(((i >> 2) * 128 + 124 + (i & 3)) * 2 + kvh)) * 64 + 8 * fq; } }
#pragma unroll
                    for (int bj = 0; bj < 2; ++bj) { const f32x4 v0 = z[bj][0], v1 = z[bj][1];
                        u32x4 w; w.x = cvt_pk_bf16(v0[0], v0[1]); w.y = cvt_pk_bf16(v0[2], v0[3]); w.z = cvt_pk_bf16(v1[0], v1[1]); w.w = cvt_pk_bf16(v1[2], v1[3]);
                        *(u32x4*)(dst + 32 * bj) = w;
                        if (win) { *(f32x4*)(win + 32 * bj) = v0; *(f32x4*)(win + 32 * bj + 4) = v1; } }
                } else if (pn < 5) {
                    bf16_t* dst = Gb + (size_t)row * 512 + (pn - 3) * 256 + wc * 32 + 8 * fq;
#pragma unroll
                    for (int bj = 0; bj < 2; ++bj) { const f32x4 v0 = z[bj][0], v1 = z[bj][1];
                        u32x4 w; w.x = cvt_pk_bf16(v0[0], v0[1]); w.y = cvt_pk_bf16(v0[2], v0[3]); w.z = cvt_pk_bf16(v1[0], v1[1]); w.w = cvt_pk_bf16(v1[2], v1[3]);
                        *(u32x4*)(dst + bj * HALF) = w; }
                } else {
                    const int f0 = (pn - 5) * 128 + wc * 32 + 8 * fq;
                    const f32x4 v0 = z[0][0] * z[1][0], v1 = z[0][1] * z[1][1];
                    u32x4 w; w.x = cvt_pk_bf16(v0[0], v0[1]); w.y = cvt_pk_bf16(v0[2], v0[3]); w.z = cvt_pk_bf16(v1[0], v1[1]); w.w = cvt_pk_bf16(v1[2], v1[3]);
                    *(u32x4*)(Ub + (size_t)row * 512 + f0) = w;
                    float* cs = nullptr;
                    if (row < MP) { const int t = row & (SEQ - 1); if (t >= SEQ - 2) cs = convP + (size_t)((row >> 13) * 2 + (t - (SEQ - 2))) * 512 + f0; }
                    else { const int i = row - MP; if ((i & 3) >= 2) cs = convS + (size_t)((i >> 2) * 2 + ((i & 3) - 2)) * 512 + f0; }
                    if (cs) { *(f32x4*)cs = v0; *(f32x4*)(cs + 4) = v1; }
                }
            }
    }
};

struct EpiPle {
    static constexpr bool PERM = true, AFTER_DRAIN = false, STATS_LDS = true, STRIP = true;
    const float* stats; const PG8_LAS unsigned char* stab; const bf16_t* pp; const bf16_t* xb; float* out;
    __device__ __forceinline__ void strip(const f32x4 (&accS)[2], const Unit& u, int wr, int wc, int fr, int fq) const {
        if (fr < 8) {
            const int row = MP + 8 * u.pm + fr, col = u.pn * BM + wr * HALF + wc * 32 + 8 * fq;
            const float r = row_rscale(stats, row) * LOG2E;
            const size_t off = (size_t)row * D + col;
            const u32x4 x = *(const u32x4*)(xb + off), p = *(const u32x4*)(pp + off);
            const f32x4 x0 = (f32x4){bf_lo(x.x), bf_hi(x.x), bf_lo(x.y), bf_hi(x.y)}, x1 = (f32x4){bf_lo(x.z), bf_hi(x.z), bf_lo(x.w), bf_hi(x.w)};
            const f32x4 p0 = (f32x4){bf_lo(p.x), bf_hi(p.x), bf_lo(p.y), bf_hi(p.y)}, p1 = (f32x4){bf_lo(p.z), bf_hi(p.z), bf_lo(p.w), bf_hi(p.w)};
            f32x4 y0, y1;
#pragma unroll
            for (int e = 0; e < 4; ++e) { y0[e] = x0[e] + __builtin_amdgcn_rcpf(1.0f + __builtin_amdgcn_exp2f(-accS[0][e] * r)) * p0[e];
                                          y1[e] = x1[e] + __builtin_amdgcn_rcpf(1.0f + __builtin_amdgcn_exp2f(-accS[1][e] * r)) * p1[e]; }
            *(f32x4*)(out + off) = y0; *(f32x4*)(out + off + 4) = y1;
        }
    }
    __device__ __forceinline__ void operator()(const f32x4 (&acc)[2][2][4][2], const Unit& u, int wr, int wc, int fr_, int fq_) const {
        int fr = fr_, fq = fq_; asm volatile("" : "+v"(fr), "+v"(fq));
        const int row0 = u.pm * BM + wr * 64 + fr, col0 = u.pn * BM + wc * 32 + 8 * fq;
#pragma unroll
        for (int am = 0; am < 4; ++am) { const int ai = am >> 1;
            u32x4 xw[4][2], pw[4][2];
#pragma unroll
            for (int m = 2 * (am & 1); m < 2 * (am & 1) + 2; ++m)
#pragma unroll
                for (int bj = 0; bj < 2; ++bj) { const size_t off = (size_t)(row0 + ai * HALF + m * 16) * D + col0 + bj * HALF; xw[m][bj] = *(const u32x4*)(xb + off); pw[m][bj] = *(const u32x4*)(pp + off); }
#pragma unroll
            for (int m = 2 * (am & 1); m < 2 * (am & 1) + 2; ++m) {
                const int row = row0 + ai * HALF + m * 16;
                const float r = row_rscale_lds(stab, row - u.pm * BM, fq) * LOG2E;
#pragma unroll
                for (int bj = 0; bj < 2; ++bj) { const size_t off = (size_t)row * D + col0 + bj * HALF; const u32x4 x = xw[m][bj], p = pw[m][bj];
                    const f32x4 x0 = (f32x4){bf_lo(x.x), bf_hi(x.x), bf_lo(x.y), bf_hi(x.y)}, x1 = (f32x4){bf_lo(x.z), bf_hi(x.z), bf_lo(x.w), bf_hi(x.w)};
                    const f32x4 p0 = (f32x4){bf_lo(p.x), bf_hi(p.x), bf_lo(p.y), bf_hi(p.y)}, p1 = (f32x4){bf_lo(p.z), bf_hi(p.z), bf_lo(p.w), bf_hi(p.w)};
                    f32x4 y0, y1;
#pragma unroll
                    for (int e = 0; e < 4; ++e) { y0[e] = x0[e] + __builtin_amdgcn_rcpf(1.0f + __builtin_amdgcn_exp2f(-acc[ai][bj][m][0][e] * r)) * p0[e];
                                                  y1[e] = x1[e] + __builtin_amdgcn_rcpf(1.0f + __builtin_amdgcn_exp2f(-acc[ai][bj][m][1][e] * r)) * p1[e]; }
                    *(f32x4*)(out + off) = y0; *(f32x4*)(out + off + 4) = y1; }
            }
        }
    }
};

template <class Epi, class Sched, bool ALIGN_EPI = false, bool SP2 = false>
__device__ __forceinline__ void gemm_phase(PG8_LAS unsigned char* lds, const Gemm g, const Sched& S, const Epi& E) {
    int tid_ = threadIdx.x; asm volatile("" : "+v"(tid_));
    const int tid = tid_, wid = __builtin_amdgcn_readfirstlane(tid >> 6), lane = tid & 63, wr = wid >> 2, wc = wid & 3, fr = lane & 15, fq = lane >> 4;
    const int K = g.K, nt = K / BK;
    unsigned voffA[2], voffB[2];
#pragma unroll
    for (int i = 0; i < 2; ++i) { int R, C; stage_rc(tid * 16 + i * 8192, R, C); const int Rb = Epi::PERM ? ((R & ~31) + perm32(R & 31)) : R;
        voffA[i] = (unsigned)(R * K + C) * 2u; voffB[i] = (unsigned)(Rb * K + C) * 2u; }
    const unsigned kstep = (unsigned)(BK * 2);
    const unsigned hstep = (unsigned)HALF * K * 2;
    const unsigned tstep = 2 * hstep;
    const unsigned ldsw = (unsigned)wid * 1024u;
    const int aoff = lds_byte(wr * 64 + fr, fq * 8), boff = lds_byte(wc * 32 + fr, fq * 8);
#define PG8_SA(b, h) (((b) * 2 + (h)) * HTB)
#define PG8_SB(b, h) ((4 + (b) * 2 + (h)) * HTB)
    const __amdgpu_buffer_rsrc_t rA = __builtin_amdgcn_make_buffer_rsrc((void*)g.A, 0, -1, 0x00020000), rB = __builtin_amdgcn_make_buffer_rsrc((void*)g.Bt, 0, -1, 0x00020000);
#define PG8_STAGE(bufoff, goff, voff, rs) do { _Pragma("unroll") for (int _i = 0; _i < 2; ++_i) \
        __builtin_amdgcn_raw_ptr_buffer_load_lds(rs, (PG8_LAS unsigned*)(lds + (bufoff) + ldsw + _i * 8192), 16, (int)(voff)[_i], (int)(goff), 0, 0); } while (0)
#define PG8_LDA(dst, b, h) do { _Pragma("unroll") for (int m = 0; m < 4; ++m) _Pragma("unroll") for (int k = 0; k < 2; ++k) dst[m][k] = *(const PG8_LAS bf16x8*)(lds + PG8_SA(b, h) + aoff + m * 2048 + k * 1024); } while (0)
#define PG8_LDB(dst, b, h) do { _Pragma("unroll") for (int n = 0; n < 2; ++n) _Pragma("unroll") for (int k = 0; k < 2; ++k) dst[n][k] = *(const PG8_LAS bf16x8*)(lds + PG8_SB(b, h) + boff + n * 2048 + k * 1024); } while (0)
#define PG8_MMA(ai, bj, At, Bt) do { __builtin_amdgcn_s_setprio(1); _Pragma("unroll") for (int m = 0; m < 4; ++m) _Pragma("unroll") for (int n = 0; n < 2; ++n) _Pragma("unroll") for (int k = 0; k < 2; ++k) \
        acc[ai][bj][m][n] = __builtin_amdgcn_mfma_f32_16x16x32_bf16(Bt[n][k], At[m][k], acc[ai][bj][m][n], 0, 0, 0); __builtin_amdgcn_s_setprio(0); } while (0)
#define PG8_WAIT_V(n) asm volatile("s_waitcnt vmcnt(" #n ")" ::: "memory")
#define PG8_WAIT_L(n) asm volatile("s_waitcnt lgkmcnt(" #n ")" ::: "memory")
#define PG8_BAR __builtin_amdgcn_s_barrier()
#define PG8_SCHED __builtin_amdgcn_sched_barrier(0)
    constexpr int STRIP_OFF = STAGE_BYTES + 16384;
    const int srow_ = 8 * (wid & 1) + (lane >> 3);
    const unsigned voffS = (unsigned)(srow_ * K) * 2u + (unsigned)(((lane & 7) ^ (srow_ & 7)) * 16);
    const int soff0 = fr * 128 + ((fq ^ (fr & 7)) << 4);
#define PG8_STAGES(b, goff) do { if constexpr (Epi::STRIP) { if (wid < 2) __builtin_amdgcn_raw_ptr_buffer_load_lds(rA, (PG8_LAS unsigned*)(lds + STRIP_OFF + (b) * 2048 + wid * 1024), 16, (int)voffS, (int)(goff), 0, 0); } } while (0)
#define PG8_LDS(b) do { if constexpr (Epi::STRIP) { Sf[0] = *(const PG8_LAS bf16x8*)(lds + STRIP_OFF + (b) * 2048 + soff0); Sf[1] = *(const PG8_LAS bf16x8*)(lds + STRIP_OFF + (b) * 2048 + (soff0 ^ 64)); } } while (0)
#define PG8_MMAS() do { if constexpr (Epi::STRIP) { if (wr == 0) { _Pragma("unroll") for (int n = 0; n < 2; ++n) _Pragma("unroll") for (int k = 0; k < 2; ++k) accS[n] = __builtin_amdgcn_mfma_f32_16x16x32_bf16(B0[n][k], Sf[k], accS[n], 0, 0, 0); } \
        else { _Pragma("unroll") for (int n = 0; n < 2; ++n) _Pragma("unroll") for (int k = 0; k < 2; ++k) accS[n] = __builtin_amdgcn_mfma_f32_16x16x32_bf16(B1[n][k], Sf[k], accS[n], 0, 0, 0); } } } while (0)
    static_assert(!Epi::STRIP || SP2, "the sample-row strip lives in the SP2 loop");
    Unit cur, nxt; int ui = 0;
    if (!S.next(0, cur)) return;
    f32x4 accS[2] = {(f32x4){0.f, 0.f, 0.f, 0.f}, (f32x4){0.f, 0.f, 0.f, 0.f}}; bf16x8 Sf[2];
    f32x4 acc[2][2][4][2];
#pragma unroll
    for (int a = 0; a < 2; ++a)
#pragma unroll
        for (int b = 0; b < 2; ++b)
#pragma unroll
            for (int m = 0; m < 4; ++m)
#pragma unroll
                for (int n = 0; n < 2; ++n) acc[a][b][m][n] = (f32x4){0.f, 0.f, 0.f, 0.f};
    bf16x8 At[4][2], B0[2][2], B1[2][2];
    unsigned cA = (unsigned)cur.pm * tstep, cB = (unsigned)cur.pn * tstep;
    unsigned cS = (unsigned)(MP + 8 * cur.pm) * K * 2;
    S.a_ready(cur);
    if constexpr (SP2) {
        PG8_STAGE(PG8_SB(0, 0), cB, voffB, rB); PG8_STAGE(PG8_SB(0, 1), cB + hstep, voffB, rB); PG8_STAGE(PG8_SA(0, 0), cA, voffA, rA); PG8_STAGES(0, cS); PG8_STAGE(PG8_SA(0, 1), cA + hstep, voffA, rA);
        if (wr == 1) PG8_BAR;
        PG8_WAIT_V(2); PG8_BAR;
        PG8_STAGE(PG8_SB(1, 0), cB + kstep, voffB, rB); PG8_STAGE(PG8_SA(1, 0), cA + kstep, voffA, rA); PG8_STAGES(1, cS + kstep); PG8_STAGE(PG8_SB(1, 1), cB + hstep + kstep, voffB, rB);
        PG8_WAIT_V(6); PG8_BAR;
    } else {
        PG8_STAGE(PG8_SB(0, 0), cB, voffB, rB); PG8_STAGE(PG8_SA(0, 0), cA, voffA, rA); PG8_STAGE(PG8_SB(0, 1), cB + hstep, voffB, rB); PG8_STAGE(PG8_SA(0, 1), cA + hstep, voffA, rA);
        if (wr == 1) PG8_BAR;
        PG8_WAIT_V(4); PG8_BAR;
        PG8_STAGE(PG8_SB(1, 0), cB + kstep, voffB, rB); PG8_STAGE(PG8_SA(1, 0), cA + kstep, voffA, rA); PG8_STAGE(PG8_SB(1, 1), cB + hstep + kstep, voffB, rB);
        PG8_WAIT_V(6); PG8_BAR;
    }
    for (;;) {
        const bool has_next = S.next(ui + 1, nxt);
        const unsigned nA = has_next ? (unsigned)nxt.pm * tstep : cA, nB = has_next ? (unsigned)nxt.pn * tstep : cB;
        const unsigned nS = has_next ? (unsigned)(MP + 8 * nxt.pm) * K * 2 : cS;
        for (int t = 0; t < nt; t += 2) {
            const bool last = (t == nt - 2);
            const unsigned a1 = cA + (unsigned)(t + 1) * kstep;
            const unsigned a2 = last ? nA : cA + (unsigned)(t + 2) * kstep, b2 = last ? nB : cB + (unsigned)(t + 2) * kstep;
            const unsigned a3 = a2 + kstep, b3 = b2 + kstep;
            const unsigned s2 = last ? nS : cS + (unsigned)(t + 2) * kstep, s3 = s2 + kstep;
            if (last && has_next) S.a_ready(nxt);
            if constexpr (Epi::STATS_LDS) { if (last) {
                int l_ = lane; asm volatile("" : "+v"(l_));
                const char* sp = (const char*)E.stats + (size_t)cur.pm * (BM * 64) + (size_t)(wid * 2048 + l_ * 16);
#pragma unroll
                for (int _i = 0; _i < 2; ++_i) __builtin_amdgcn_global_load_lds((const unsigned*)(sp + _i * 1024), (PG8_LAS unsigned*)(lds + STAGE_BYTES + wid * 2048 + _i * 1024), 16, 0, 0); } }
            if constexpr (SP2) {
            PG8_LDB(B0, 0, 0); PG8_LDB(B1, 0, 1); PG8_SCHED; PG8_LDA(At, 0, 0); PG8_LDS(0); PG8_STAGE(PG8_SA(1, 1), a1 + hstep, voffA, rA);
            PG8_WAIT_V(8); PG8_WAIT_L(0); PG8_BAR; PG8_MMA(0, 0, At, B0); PG8_MMA(0, 1, At, B1); PG8_MMAS(); PG8_BAR; PG8_SCHED;
            PG8_LDA(At, 0, 1); PG8_STAGE(PG8_SB(0, 0), b2, voffB, rB); PG8_STAGE(PG8_SB(0, 1), b2 + hstep, voffB, rB); PG8_STAGE(PG8_SA(0, 0), a2, voffA, rA); PG8_STAGES(0, s2);
            PG8_WAIT_V(8); PG8_WAIT_L(0); PG8_BAR; PG8_MMA(1, 0, At, B0); PG8_MMA(1, 1, At, B1); PG8_BAR; PG8_SCHED;
            PG8_LDB(B0, 1, 0); PG8_LDB(B1, 1, 1); PG8_SCHED; PG8_LDA(At, 1, 0); PG8_LDS(1); PG8_STAGE(PG8_SA(0, 1), a2 + hstep, voffA, rA);
            PG8_WAIT_V(8); PG8_WAIT_L(0); PG8_BAR; PG8_MMA(0, 0, At, B0); PG8_MMA(0, 1, At, B1); PG8_MMAS(); PG8_BAR; PG8_SCHED;
            PG8_LDA(At, 1, 1); PG8_STAGE(PG8_SB(1, 0), b3, voffB, rB); PG8_STAGE(PG8_SB(1, 1), b3 + hstep, voffB, rB); PG8_STAGE(PG8_SA(1, 0), a3, voffA, rA); PG8_STAGES(1, s3);
            PG8_WAIT_V(8); PG8_WAIT_L(0); PG8_BAR; PG8_MMA(1, 0, At, B0); PG8_MMA(1, 1, At, B1); PG8_BAR; PG8_SCHED;
            } else {
            PG8_LDB(B0, 0, 0); PG8_SCHED; PG8_LDA(At, 0, 0); PG8_STAGE(PG8_SA(1, 1), a1 + hstep, voffA, rA);
            PG8_WAIT_L(8); PG8_BAR; PG8_WAIT_L(0); PG8_MMA(0, 0, At, B0); PG8_BAR; PG8_SCHED;
            PG8_LDB(B1, 0, 1); PG8_STAGE(PG8_SB(0, 0), b2, voffB, rB);
            PG8_BAR; PG8_WAIT_L(0); PG8_MMA(0, 1, At, B1); PG8_BAR;
            PG8_LDA(At, 0, 1); PG8_STAGE(PG8_SA(0, 0), a2, voffA, rA);
            PG8_BAR; PG8_WAIT_L(0); PG8_MMA(1, 0, At, B0); PG8_BAR; PG8_SCHED;
            PG8_STAGE(PG8_SB(0, 1), b2 + hstep, voffB, rB);
            PG8_WAIT_V(6); PG8_BAR; PG8_MMA(1, 1, At, B1); PG8_BAR;
            PG8_LDB(B0, 1, 0); PG8_SCHED; PG8_LDA(At, 1, 0); PG8_STAGE(PG8_SA(0, 1), a2 + hstep, voffA, rA);
            PG8_WAIT_L(8); PG8_BAR; PG8_WAIT_L(0); PG8_MMA(0, 0, At, B0); PG8_BAR; PG8_SCHED;
            PG8_LDB(B1, 1, 1); PG8_STAGE(PG8_SB(1, 0), b3, voffB, rB);
            PG8_BAR; PG8_WAIT_L(0); PG8_MMA(0, 1, At, B1); PG8_BAR;
            PG8_LDA(At, 1, 1); PG8_STAGE(PG8_SA(1, 0), a3, voffA, rA);
            PG8_BAR; PG8_WAIT_L(0); PG8_MMA(1, 0, At, B0); PG8_BAR; PG8_SCHED;
            PG8_STAGE(PG8_SB(1, 1), b3 + hstep, voffB, rB);
            PG8_WAIT_V(6); PG8_BAR; PG8_MMA(1, 1, At, B1); PG8_BAR;
            }
        }
        if constexpr (ALIGN_EPI) { if (wr == 0) PG8_BAR; }
        if constexpr (!Epi::AFTER_DRAIN) { E(acc, cur, wr, wc, fr, fq); if constexpr (Epi::STRIP) { E.strip(accS, cur, wr, wc, fr, fq); accS[0] = (f32x4){0.f, 0.f, 0.f, 0.f}; accS[1] = accS[0]; } S.done(cur); }
        if (!has_next) break;
#pragma unroll
        for (int a = 0; a < 2; ++a)
#pragma unroll
            for (int b = 0; b < 2; ++b)
#pragma unroll
                for (int m = 0; m < 4; ++m)
#pragma unroll
                    for (int n = 0; n < 2; ++n) acc[a][b][m][n] = (f32x4){0.f, 0.f, 0.f, 0.f};
        cur = nxt; cA = nA; cB = nB; cS = nS; ++ui;
        if constexpr (ALIGN_EPI) { if (wr == 1) PG8_BAR; }
    }
    PG8_WAIT_V(0);
    if constexpr (!ALIGN_EPI) { if (wr == 0) PG8_BAR; }
    PG8_BAR;
    if constexpr (Epi::AFTER_DRAIN) { E.fused(acc, cur, wr, wc, fr, fq, lds, wid, lane); S.done(cur); }
#undef PG8_SA
#undef PG8_SB
#undef PG8_STAGE
#undef PG8_STAGES
#undef PG8_LDS
#undef PG8_MMAS
#undef PG8_LDA
#undef PG8_LDB
#undef PG8_MMA
#undef PG8_WAIT_V
#undef PG8_WAIT_L
#undef PG8_BAR
#undef PG8_SCHED
}
}
#define GAS __attribute__((address_space(1)))
#define LAS __attribute__((address_space(3)))
typedef unsigned short bf16;
typedef unsigned v4u __attribute__((ext_vector_type(4)));
typedef float f32x4 __attribute__((ext_vector_type(4)));
typedef short bf16x8 __attribute__((ext_vector_type(8)));
typedef GAS unsigned gu32;
typedef GAS unsigned long long gu64;
#define RLX_AGENT __ATOMIC_RELAXED, __HIP_MEMORY_SCOPE_AGENT
#define LDS_WAIT() asm volatile("s_waitcnt lgkmcnt(0)" ::: "memory")
#define VM_WAIT() asm volatile("s_waitcnt vmcnt(0)" ::: "memory")
__device__ __forceinline__ unsigned long long rt() { return __builtin_amdgcn_s_memrealtime(); }
__device__ __forceinline__ unsigned f2bf(float f) { unsigned u = __builtin_bit_cast(unsigned, f); return (u + 0x7fffu + ((u >> 16) & 1u)) >> 16; }
__device__ __forceinline__ unsigned pk2(float lo, float hi) { return f2bf(lo) | (f2bf(hi) << 16); }

#define XB_TMO      128
#define XB_XCNT(j)  (256  + 64 * (j))
#define XB_XSUB(j)  (1280 + 64 * (j))
#define XB_XGEN(j)  (2304 + 64 * (j))
#define XB_TOP      3328
#define XB_TOPGEN   3392
#define XCD_BAR_WORDS 3456
#define XB_SPIN_CAP (1u << 18)

__device__ __forceinline__ unsigned xb_ld(unsigned* p)              { return __hip_atomic_load(p, __ATOMIC_RELAXED, __HIP_MEMORY_SCOPE_AGENT); }
__device__ __forceinline__ unsigned xb_add(unsigned* p, unsigned v) { return __hip_atomic_fetch_add(p, v, __ATOMIC_RELAXED, __HIP_MEMORY_SCOPE_AGENT); }
__device__ __forceinline__ unsigned xb_xcc_id() { return (unsigned)__builtin_amdgcn_s_getreg((3 << 11) | 20) & 0xFu; }
#define XB_SPIN(cond, bar) do { unsigned _sp = 0; while (cond) { __builtin_amdgcn_s_sleep(1); \
    if ((++_sp & 255u) == 0u) { if (xb_ld(&(bar)[XB_TMO])) break; if (_sp > XB_SPIN_CAP) { atomicAdd(&(bar)[XB_TMO], 1u); break; } } } } while (0)

struct XcdBarrier {
    unsigned* bar; unsigned x;
    volatile LAS unsigned* st;
};

__device__ __forceinline__ XcdBarrier xcd_barrier_post(unsigned* bar, volatile LAS unsigned* st) {
    XcdBarrier b; b.bar = bar; b.x = xb_xcc_id(); b.st = st;
    if (threadIdx.x == 0) (void)xb_add(&bar[XB_XCNT(b.x)], 1u);
    return b;
}
__device__ __forceinline__ void xcd_barrier_complete(unsigned* bar, unsigned x, unsigned& nloc, unsigned& nx) {
    const unsigned G = gridDim.x * gridDim.y * gridDim.z;
    unsigned sum, cnt, mine, sp = 0u;
    for (;;) {
        sum = 0u; cnt = 0u; mine = 0u;
#pragma unroll
        for (unsigned j = 0; j < 16; ++j) { const unsigned c = xb_ld(&bar[XB_XCNT(j)]); sum += c; cnt += (c > 0u) ? 1u : 0u; mine = (j == x) ? c : mine; }
        if (sum == G) break;
        __builtin_amdgcn_s_sleep(1);
        if ((++sp & 255u) == 0u) { if (xb_ld(&bar[XB_TMO])) break; if (sp > XB_SPIN_CAP) { atomicAdd(&bar[XB_TMO], 1u); break; } }
    }
    nloc = mine > 0u ? mine : 1u; nx = cnt > 0u ? cnt : 1u;
}

__device__ __forceinline__ void xcd_barrier(const XcdBarrier& b) {
    asm volatile("s_waitcnt vmcnt(0)" ::: "memory");
    __syncthreads();
    if (threadIdx.x == 0) {
        unsigned* bar = b.bar;
        __builtin_amdgcn_s_waitcnt(0);
        unsigned nloc = b.st[0], nx = b.st[1];
        if (nloc == 0u) { xcd_barrier_complete(bar, b.x, nloc, nx); b.st[0] = nloc; b.st[1] = nx; }
        const unsigned old = xb_add(&bar[XB_XSUB(b.x)], 1u);
        const unsigned gen = old / nloc;
        if (old + 1u == (gen + 1u) * nloc) {
            __builtin_amdgcn_fence(__ATOMIC_RELEASE, "agent");
            asm volatile("s_waitcnt vmcnt(0)" ::: "memory");
            const unsigned og = xb_add(&bar[XB_TOP], 1u);
            const unsigned tg = og / nx;
            if (og + 1u == (tg + 1u) * nx) xb_add(&bar[XB_TOPGEN], 1u);
            asm volatile("buffer_inv sc1" ::: "memory");
            if (og + 1u != (tg + 1u) * nx) XB_SPIN(xb_ld(&bar[XB_TOPGEN]) == tg, bar);
            xb_add(&bar[XB_XGEN(b.x)], 1u);
            asm volatile("s_waitcnt vmcnt(0)" ::: "memory");
        } else {
            asm volatile("buffer_inv sc1" ::: "memory");
            XB_SPIN(xb_ld(&bar[XB_XGEN(b.x)]) == gen, bar);
            asm volatile("s_waitcnt vmcnt(0)" ::: "memory");
        }
    }
    __syncthreads();
}
namespace att {
typedef short bf16x8 __attribute__((ext_vector_type(8)));
typedef short s16x4 __attribute__((ext_vector_type(4)));
typedef float f32x16 __attribute__((ext_vector_type(16)));
typedef float f32x4 __attribute__((ext_vector_type(4)));
typedef unsigned u32x4 __attribute__((ext_vector_type(4)));
typedef unsigned u32x2 __attribute__((ext_vector_type(2)));
typedef unsigned short bf16_t;
#define ATT_LAS __attribute__((address_space(3)))
constexpr int KCH = 4112;
constexpr int VDH = 16384 + 64;
constexpr int BIASW = 192;
constexpr int L_K = 0, L_V = 8 * KCH, L_BIAS = L_V + 2 * VDH, L_END = L_BIAS + 8 * BIASW * 4;
constexpr int IMG1 = 73728;
static_assert(L_V % 16 == 0 && L_BIAS % 16 == 0 && L_END <= IMG1 && IMG1 + L_BIAS <= 151552, "attention LDS map");
__device__ __forceinline__ int crow(int r, int hi) { return (r & 3) + 8 * (r >> 2) + 4 * hi; }
__device__ __forceinline__ unsigned cvtpk(float lo, float hi) { unsigned r; asm volatile("v_cvt_pk_bf16_f32 %0, %1, %2" : "=v"(r) : "v"(lo), "v"(hi)); return r; }
__device__ __forceinline__ s16x4 vtr(const ATT_LAS unsigned char* p) { typedef short v4i16_t __attribute__((ext_vector_type(4))); return __builtin_bit_cast(s16x4, __builtin_amdgcn_ds_read_tr16_b64_v4i16((ATT_LAS v4i16_t*)p)); }

struct Tensors {
    const bf16_t *Q, *Kb, *Vb, *Gb, *Ub, *CK, *CV;
    bf16_t* MIX;
    const float *wconv, *sconv, *sinks, *relb;
};

template <bool FULL>
__device__ __forceinline__ void wave_unit(const Tensors& T, ATT_LAS unsigned char* lds, const bf16x8 (&qf)[4], int g, int head, int ql, int r32, int hi, int lane, bool do_store, size_t orow, int img = 0) {
    f32x16 s[5];
    const ATT_LAS unsigned char* kbase = lds + img + L_K + hi * KCH + (32 * g + r32) * 16;
#pragma unroll
    for (int t = 0; t < 5; ++t) {
        s[t] = (f32x16){0.f, 0.f, 0.f, 0.f, 0.f, 0.f, 0.f, 0.f, 0.f, 0.f, 0.f, 0.f, 0.f, 0.f, 0.f, 0.f};
#pragma unroll
        for (int ks = 0; ks < 4; ++ks) { const bf16x8 kf = *(const ATT_LAS bf16x8*)(kbase + 2 * ks * KCH + t * 512); s[t] = __builtin_amdgcn_mfma_f32_32x32x16_bf16(kf, qf[ks], s[t], 0, 0, 0); }
    }
    const ATT_LAS float* bt = (const ATT_LAS float*)(lds + L_BIAS) + head * BIASW + (ql - 4 * hi);
    const float sink2 = T.sinks[head] * LOG2E;
    const int qc = ql - 4 * hi;
    float mx = -1e30f;
#pragma unroll
    for (int t = 0; t < 5; ++t)
#pragma unroll
        for (int r = 0; r < 16; ++r) {
            const int c0 = (r & 3) + 8 * (r >> 2);
            float v = s[t][r] + bt[160 - 32 * t - c0];
            if (t == 0) v = (c0 > qc) ? v : -1e30f;
            if (t == 4) v = (c0 <= qc) ? v : -1e30f;
            if (!FULL) { if (32 * g + 32 * t + 31 < 128) v = -1e30f; else if (32 * g + 32 * t < 128) v = (32 * g + 32 * t + c0 + 4 * hi >= 128) ? v : -1e30f; }
            s[t][r] = v; mx = fmaxf(mx, v);
        }
    mx = fmaxf(mx, __shfl_xor(mx, 32)); mx = fmaxf(mx, sink2);
    float sum = 0.f;
#pragma unroll
    for (int t = 0; t < 5; ++t)
#pragma unroll
        for (int r = 0; r < 16; ++r) { const float p = __builtin_amdgcn_exp2f(s[t][r] - mx); s[t][r] = p; sum += p; }
    sum += __shfl_xor(sum, 32); sum += __builtin_amdgcn_exp2f(sink2 - mx);
    const float rl = __builtin_amdgcn_rcpf(sum);
    f32x16 o[2];
    o[0] = (f32x16){0.f, 0.f, 0.f, 0.f, 0.f, 0.f, 0.f, 0.f, 0.f, 0.f, 0.f, 0.f, 0.f, 0.f, 0.f, 0.f}; o[1] = o[0];
    const ATT_LAS unsigned char* vbase = lds + img + L_V + (32 * g + 4 * hi + ((lane & 15) >> 2)) * 64 + ((lane >> 4) & 1) * 32 + (lane & 3) * 8;
#pragma unroll
    for (int t = 0; t < 5; ++t)
#pragma unroll
        for (int ks = 0; ks < 2; ++ks) {
            u32x4 pw; pw.x = cvtpk(s[t][8 * ks + 0], s[t][8 * ks + 1]); pw.y = cvtpk(s[t][8 * ks + 2], s[t][8 * ks + 3]); pw.z = cvtpk(s[t][8 * ks + 4], s[t][8 * ks + 5]); pw.w = cvtpk(s[t][8 * ks + 6], s[t][8 * ks + 7]);
            const bf16x8 pf = __builtin_bit_cast(bf16x8, pw);
#pragma unroll
            for (int dt = 0; dt < 2; ++dt) {
                const ATT_LAS unsigned char* vp = vbase + dt * VDH + (32 * t + 16 * ks) * 64;
                const s16x4 lo = vtr(vp), hh = vtr(vp + 512);
                const bf16x8 vf = (bf16x8){lo[0], lo[1], lo[2], lo[3], hh[0], hh[1], hh[2], hh[3]};
                o[dt] = __builtin_amdgcn_mfma_f32_32x32x16_bf16(vf, pf, o[dt], 0, 0, 0);
            }
        }
    if (do_store) {
        bf16_t* Op = T.MIX + orow * 1024 + head * 64 + 4 * hi;
#pragma unroll
        for (int dt = 0; dt < 2; ++dt)
#pragma unroll
            for (int i = 0; i < 4; ++i) { u32x2 w; w.x = cvtpk(o[dt][4 * i] * rl, o[dt][4 * i + 1] * rl); w.y = cvtpk(o[dt][4 * i + 2] * rl, o[dt][4 * i + 3] * rl);
                *(u32x2*)(Op + 32 * dt + 8 * i) = w; }
    }
}

__device__ __forceinline__ void unit(const Tensors& T, ATT_LAS unsigned char* lds, bool sample, int blk, int kvh) {
    const int tid = threadIdx.x, lane = tid & 63, wid = __builtin_amdgcn_readfirstlane(tid >> 6), r32 = lane & 31, hi = lane >> 5;
    const int R0 = sample ? (MP + blk * 4) : blk * 128;
    const bool prev_valid = sample ? true : ((blk & 63) != 0);
    const int curN = sample ? 4 : 128;
    const bf16_t* prevK = sample ? T.CK + (size_t)blk * 128 * 128 : T.Kb + (size_t)(R0 - 128) * 128;
    const bf16_t* prevV = sample ? T.CV + (size_t)blk * 128 * 128 : T.Vb + (size_t)(R0 - 128) * 128;
    const bf16_t* curK = T.Kb + (size_t)R0 * 128; const bf16_t* curV = T.Vb + (size_t)R0 * 128;
    u32x4 kv[4], vv[4];
#pragma unroll
    for (int i = 0; i < 4; ++i) {
        const int c = tid + 512 * i, key = c >> 3, ch = c & 7;
        kv[i] = (u32x4){0u, 0u, 0u, 0u}; vv[i] = (u32x4){0u, 0u, 0u, 0u};
        if (key < 128) { if (prev_valid) { kv[i] = *(const u32x4*)(prevK + (size_t)key * 128 + kvh * 64 + ch * 8); vv[i] = *(const u32x4*)(prevV + (size_t)key * 128 + kvh * 64 + ch * 8); } }
        else { int kr = key - 128; kr = kr < curN ? kr : curN - 1; kv[i] = *(const u32x4*)(curK + (size_t)kr * 128 + kvh * 64 + ch * 8); vv[i] = *(const u32x4*)(curV + (size_t)kr * 128 + kvh * 64 + ch * 8); }
    }
    const int nwu = sample ? 4 : 16;
    const int ql = sample ? (r32 < 4 ? r32 : 3) : r32;
    bf16x8 qf[4], qn[4];
    { const int wu = wid < nwu ? wid : 0, hq = wu & 3, g = sample ? 0 : (wu >> 2);
      const bf16_t* Qp = T.Q + (size_t)(R0 + 32 * g + ql) * 512 + (kvh * 4 + hq) * 64 + hi * 8;
#pragma unroll
      for (int ks = 0; ks < 4; ++ks) qf[ks] = *(const bf16x8*)(Qp + ks * 16); }
    {
        const int cc = tid & 31, c0 = 256 * kvh + 8 * cc, rg = tid >> 5;
        float w0[8], w1[8], w2[8];
#pragma unroll
        for (int e = 0; e < 8; ++e) { w0[e] = T.wconv[c0 + e]; w1[e] = T.wconv[512 + c0 + e]; w2[e] = T.wconv[1024 + c0 + e]; }
#define ldu(row, u) do { const u32x4 w_ = *(const u32x4*)(T.Ub + (size_t)(row) * 512 + c0); \
            u[0] = bf_lo(w_.x); u[1] = bf_hi(w_.x); u[2] = bf_lo(w_.y); u[3] = bf_hi(w_.y); u[4] = bf_lo(w_.z); u[5] = bf_hi(w_.z); u[6] = bf_lo(w_.w); u[7] = bf_hi(w_.w); } while (0)
        if (!sample) {
            const int ra = R0 + 8 * rg;
            const bool seq_start = ((blk & 63) == 0) && (rg == 0);
            u32x4 uw[10], gw[8];
#pragma unroll
            for (int j = 0; j < 10; ++j) uw[j] = (j < 2 && seq_start) ? (u32x4){0u, 0u, 0u, 0u} : *(const u32x4*)(T.Ub + (size_t)(ra - 2 + j) * 512 + c0);
#pragma unroll
            for (int j = 0; j < 8; ++j) gw[j] = *(const u32x4*)(T.Gb + (size_t)(ra + j) * 512 + c0);
#pragma unroll
            for (int j = 0; j < 8; ++j) {
                const float um2[8] = {bf_lo(uw[j].x), bf_hi(uw[j].x), bf_lo(uw[j].y), bf_hi(uw[j].y), bf_lo(uw[j].z), bf_hi(uw[j].z), bf_lo(uw[j].w), bf_hi(uw[j].w)};
                const float um1[8] = {bf_lo(uw[j + 1].x), bf_hi(uw[j + 1].x), bf_lo(uw[j + 1].y), bf_hi(uw[j + 1].y), bf_lo(uw[j + 1].z), bf_hi(uw[j + 1].z), bf_lo(uw[j + 1].w), bf_hi(uw[j + 1].w)};
                const float u0[8] = {bf_lo(uw[j + 2].x), bf_hi(uw[j + 2].x), bf_lo(uw[j + 2].y), bf_hi(uw[j + 2].y), bf_lo(uw[j + 2].z), bf_hi(uw[j + 2].z), bf_lo(uw[j + 2].w), bf_hi(uw[j + 2].w)};
                const float gb[8] = {bf_lo(gw[j].x), bf_hi(gw[j].x), bf_lo(gw[j].y), bf_hi(gw[j].y), bf_lo(gw[j].z), bf_hi(gw[j].z), bf_lo(gw[j].w), bf_hi(gw[j].w)};
                float y[8];
#pragma unroll
                for (int e = 0; e < 8; ++e) y[e] = gb[e] * (w0[e] * um2[e] + w1[e] * um1[e] + w2[e] * u0[e]);
                u32x4 w; w.x = cvtpk(y[0], y[1]); w.y = cvtpk(y[2], y[3]); w.z = cvtpk(y[4], y[5]); w.w = cvtpk(y[6], y[7]);
                *(u32x4*)(T.MIX + (size_t)(ra + j) * 1024 + 512 + c0) = w;
            }
        } else if (rg < 4) {
            const int row = R0 + rg;
            float ua[3][8];
#pragma unroll
            for (int k = 0; k < 3; ++k) { const int ss = rg - 2 + k;
                if (ss >= 0) ldu(R0 + ss, ua[k]);
                else { const float* sp = T.sconv + (size_t)(blk * 2 + (ss + 2)) * 512 + c0;
#pragma unroll
                    for (int e = 0; e < 8; ++e) ua[k][e] = sp[e]; } }
            const u32x4 gw = *(const u32x4*)(T.Gb + (size_t)row * 512 + c0);
            const float gb[8] = {bf_lo(gw.x), bf_hi(gw.x), bf_lo(gw.y), bf_hi(gw.y), bf_lo(gw.z), bf_hi(gw.z), bf_lo(gw.w), bf_hi(gw.w)};
            float y[8];
#pragma unroll
            for (int e = 0; e < 8; ++e) y[e] = gb[e] * (w0[e] * ua[0][e] + w1[e] * ua[1][e] + w2[e] * ua[2][e]);
            u32x4 w; w.x = cvtpk(y[0], y[1]); w.y = cvtpk(y[2], y[3]); w.z = cvtpk(y[4], y[5]); w.w = cvtpk(y[6], y[7]);
            *(u32x4*)(T.MIX + (size_t)row * 1024 + 512 + c0) = w;
        }
    }
#undef ldu
#pragma unroll
    for (int i = 0; i < 4; ++i) {
        const int c = tid + 512 * i, key = c >> 3, ch = c & 7;
        *(ATT_LAS u32x4*)(lds + L_K + ch * KCH + key * 16) = kv[i];
        *(ATT_LAS u32x4*)(lds + L_V + (ch >> 2) * VDH + key * 64 + (ch & 3) * 16) = vv[i];
    }
    __syncthreads();
    for (int wu = wid; wu < nwu; wu += 8) {
        const int hq = wu & 3, g = sample ? 0 : (wu >> 2), head = kvh * 4 + hq;
        if (wu + 8 < nwu) { const int g2 = (wu + 8) >> 2; const bf16_t* Qp = T.Q + (size_t)(R0 + 32 * g2 + ql) * 512 + head * 64 + hi * 8;
#pragma unroll
            for (int ks = 0; ks < 4; ++ks) qn[ks] = *(const bf16x8*)(Qp + ks * 16); }
        const bool do_store = !sample || r32 < 4; const size_t orow = (size_t)(R0 + 32 * g + ql);
        if (prev_valid) wave_unit<true>(T, lds, qf, g, head, ql, r32, hi, lane, do_store, orow);
        else            wave_unit<false>(T, lds, qf, g, head, ql, r32, hi, lane, do_store, orow);
#pragma unroll
        for (int ks = 0; ks < 4; ++ks) qf[ks] = qn[ks];
    }
    __syncthreads();
}
__device__ __forceinline__ void sample_conv(const Tensors& T, int blk, int kvh, int t) {
    const int cc = t & 31, c0 = 256 * kvh + 8 * cc, rg = t >> 5;
    float w0[8], w1[8], w2[8];
#pragma unroll
    for (int e = 0; e < 8; ++e) { w0[e] = T.wconv[c0 + e]; w1[e] = T.wconv[512 + c0 + e]; w2[e] = T.wconv[1024 + c0 + e]; }
#define ldu(row, u) do { const u32x4 w_ = *(const u32x4*)(T.Ub + (size_t)(row) * 512 + c0); \
        u[0] = bf_lo(w_.x); u[1] = bf_hi(w_.x); u[2] = bf_lo(w_.y); u[3] = bf_hi(w_.y); u[4] = bf_lo(w_.z); u[5] = bf_hi(w_.z); u[6] = bf_lo(w_.w); u[7] = bf_hi(w_.w); } while (0)
        if (rg < 4) { const int R0 = MP + blk * 4;
            const int row = R0 + rg;
            float ua[3][8];
#pragma unroll
            for (int k = 0; k < 3; ++k) { const int ss = rg - 2 + k;
                if (ss >= 0) ldu(R0 + ss, ua[k]);
                else { const float* sp = T.sconv + (size_t)(blk * 2 + (ss + 2)) * 512 + c0;
#pragma unroll
                    for (int e = 0; e < 8; ++e) ua[k][e] = sp[e]; } }
            const u32x4 gw = *(const u32x4*)(T.Gb + (size_t)row * 512 + c0);
            const float gb[8] = {bf_lo(gw.x), bf_hi(gw.x), bf_lo(gw.y), bf_hi(gw.y), bf_lo(gw.z), bf_hi(gw.z), bf_lo(gw.w), bf_hi(gw.w)};
            float y[8];
#pragma unroll
            for (int e = 0; e < 8; ++e) y[e] = gb[e] * (w0[e] * ua[0][e] + w1[e] * ua[1][e] + w2[e] * ua[2][e]);
            u32x4 w; w.x = cvtpk(y[0], y[1]); w.y = cvtpk(y[2], y[3]); w.z = cvtpk(y[4], y[5]); w.w = cvtpk(y[6], y[7]);
            *(u32x4*)(T.MIX + (size_t)row * 1024 + 512 + c0) = w;
        }
#undef ldu
}
__device__ __forceinline__ void pair(const Tensors& T, ATT_LAS unsigned char* lds, int blk, int kvh) {
    constexpr bool sample = false;
    const int tid = threadIdx.x, lane = tid & 63, wid = __builtin_amdgcn_readfirstlane(tid >> 6), r32 = lane & 31, hi = lane >> 5;
    const int R0 = sample ? (MP + blk * 4) : blk * 128;
    const bool prev_valid = sample ? true : ((blk & 63) != 0);
    const int curN = sample ? 4 : 128;
    const bf16_t* prevK = sample ? T.CK + (size_t)blk * 128 * 128 : T.Kb + (size_t)(R0 - 128) * 128;
    const bf16_t* prevV = sample ? T.CV + (size_t)blk * 128 * 128 : T.Vb + (size_t)(R0 - 128) * 128;
    const bf16_t* curK = T.Kb + (size_t)R0 * 128; const bf16_t* curV = T.Vb + (size_t)R0 * 128;
    u32x4 kv[4], vv[4];
#pragma unroll
    for (int i = 0; i < 4; ++i) {
        const int c = tid + 512 * i, key = c >> 3, ch = c & 7;
        kv[i] = (u32x4){0u, 0u, 0u, 0u}; vv[i] = (u32x4){0u, 0u, 0u, 0u};
        if (key < 128) { if (prev_valid) { kv[i] = *(const u32x4*)(prevK + (size_t)key * 128 + kvh * 64 + ch * 8); vv[i] = *(const u32x4*)(prevV + (size_t)key * 128 + kvh * 64 + ch * 8); } }
        else { int kr = key - 128; kr = kr < curN ? kr : curN - 1; kv[i] = *(const u32x4*)(curK + (size_t)kr * 128 + kvh * 64 + ch * 8); vv[i] = *(const u32x4*)(curV + (size_t)kr * 128 + kvh * 64 + ch * 8); }
    }
    const int nwu = sample ? 4 : 16;
    const int ql = sample ? (r32 < 4 ? r32 : 3) : r32;
    bf16x8 qf[4], qn[4];
    { const int wu = wid < nwu ? wid : 0, hq = wu & 3, g = sample ? 0 : (wu >> 2);
      const bf16_t* Qp = T.Q + (size_t)(R0 + 32 * g + ql) * 512 + (kvh * 4 + hq) * 64 + hi * 8;
#pragma unroll
      for (int ks = 0; ks < 4; ++ks) qf[ks] = *(const bf16x8*)(Qp + ks * 16); }
    {
        const int cc = tid & 31, c0 = 256 * kvh + 8 * cc, rg = tid >> 5;
        float w0[8], w1[8], w2[8];
#pragma unroll
        for (int e = 0; e < 8; ++e) { w0[e] = T.wconv[c0 + e]; w1[e] = T.wconv[512 + c0 + e]; w2[e] = T.wconv[1024 + c0 + e]; }
#define ldu(row, u) do { const u32x4 w_ = *(const u32x4*)(T.Ub + (size_t)(row) * 512 + c0); \
            u[0] = bf_lo(w_.x); u[1] = bf_hi(w_.x); u[2] = bf_lo(w_.y); u[3] = bf_hi(w_.y); u[4] = bf_lo(w_.z); u[5] = bf_hi(w_.z); u[6] = bf_lo(w_.w); u[7] = bf_hi(w_.w); } while (0)
        if (!sample) {
            const int ra = R0 + 8 * rg;
            const bool seq_start = ((blk & 63) == 0) && (rg == 0);
            u32x4 uw[10], gw[8];
#pragma unroll
            for (int j = 0; j < 10; ++j) uw[j] = (j < 2 && seq_start) ? (u32x4){0u, 0u, 0u, 0u} : *(const u32x4*)(T.Ub + (size_t)(ra - 2 + j) * 512 + c0);
#pragma unroll
            for (int j = 0; j < 8; ++j) gw[j] = *(const u32x4*)(T.Gb + (size_t)(ra + j) * 512 + c0);
#pragma unroll
            for (int j = 0; j < 8; ++j) {
                const float um2[8] = {bf_lo(uw[j].x), bf_hi(uw[j].x), bf_lo(uw[j].y), bf_hi(uw[j].y), bf_lo(uw[j].z), bf_hi(uw[j].z), bf_lo(uw[j].w), bf_hi(uw[j].w)};
                const float um1[8] = {bf_lo(uw[j + 1].x), bf_hi(uw[j + 1].x), bf_lo(uw[j + 1].y), bf_hi(uw[j + 1].y), bf_lo(uw[j + 1].z), bf_hi(uw[j + 1].z), bf_lo(uw[j + 1].w), bf_hi(uw[j + 1].w)};
                const float u0[8] = {bf_lo(uw[j + 2].x), bf_hi(uw[j + 2].x), bf_lo(uw[j + 2].y), bf_hi(uw[j + 2].y), bf_lo(uw[j + 2].z), bf_hi(uw[j + 2].z), bf_lo(uw[j + 2].w), bf_hi(uw[j + 2].w)};
                const float gb[8] = {bf_lo(gw[j].x), bf_hi(gw[j].x), bf_lo(gw[j].y), bf_hi(gw[j].y), bf_lo(gw[j].z), bf_hi(gw[j].z), bf_lo(gw[j].w), bf_hi(gw[j].w)};
                float y[8];
#pragma unroll
                for (int e = 0; e < 8; ++e) y[e] = gb[e] * (w0[e] * um2[e] + w1[e] * um1[e] + w2[e] * u0[e]);
                u32x4 w; w.x = cvtpk(y[0], y[1]); w.y = cvtpk(y[2], y[3]); w.z = cvtpk(y[4], y[5]); w.w = cvtpk(y[6], y[7]);
                *(u32x4*)(T.MIX + (size_t)(ra + j) * 1024 + 512 + c0) = w;
            }
        }
    }
#undef ldu
#pragma unroll
    for (int i = 0; i < 4; ++i) {
        const int c = tid + 512 * i, key = c >> 3, ch = c & 7;
        *(ATT_LAS u32x4*)(lds + L_K + ch * KCH + key * 16) = kv[i];
        *(ATT_LAS u32x4*)(lds + L_V + (ch >> 2) * VDH + key * 64 + (ch & 3) * 16) = vv[i];
    }
    __syncthreads();
    const int R0s = MP + blk * 4;
    {
        const bf16_t* cK = T.CK + (size_t)blk * 128 * 128 + kvh * 64; const bf16_t* cV = T.CV + (size_t)blk * 128 * 128 + kvh * 64;
        const bf16_t* nK = T.Kb + (size_t)R0s * 128 + kvh * 64;       const bf16_t* nV = T.Vb + (size_t)R0s * 128 + kvh * 64;
#pragma unroll
        for (int q = 0; q < 4; ++q) { const int idx = wid * 4 + q, ch = idx >> 2, kq = idx & 3, key = 64 * kq + lane;
            const int kr = (key - 128) < 3 ? (key - 128) : 3;
            const bf16_t* src = (key < 128) ? cK + (size_t)key * 128 + ch * 8 : nK + (size_t)kr * 128 + ch * 8;
            __builtin_amdgcn_global_load_lds((const unsigned*)src, (ATT_LAS unsigned*)(lds + IMG1 + L_K + ch * KCH + kq * 1024), 16, 0, 0); }
#pragma unroll
        for (int q = 0; q < 4; ++q) { const int idx = wid * 4 + q, h = idx >> 4, j = idx & 15, key = 16 * j + (lane >> 2), c4 = lane & 3;
            const int kr = (key - 128) < 3 ? (key - 128) : 3;
            const bf16_t* src = (key < 128) ? cV + (size_t)key * 128 + (4 * h + c4) * 8 : nV + (size_t)kr * 128 + (4 * h + c4) * 8;
            __builtin_amdgcn_global_load_lds((const unsigned*)src, (ATT_LAS unsigned*)(lds + IMG1 + L_V + h * VDH + j * 1024), 16, 0, 0); }
    }
    const int qls = r32 < 4 ? r32 : 3;
#pragma nounroll
    for (int pass = 0; pass < 2; ++pass) {
        const int wu = wid + 8 * pass, hq = wu & 3, g = wu >> 2, head = kvh * 4 + hq;
        if (pass == 0) { const int g2 = (wu + 8) >> 2; const bf16_t* Qp = T.Q + (size_t)(R0 + 32 * g2 + ql) * 512 + head * 64 + hi * 8;
#pragma unroll
            for (int ks = 0; ks < 4; ++ks) qn[ks] = *(const bf16x8*)(Qp + ks * 16); }
        else if (wid < 4) { int r0s_ = R0s; asm volatile("" : "+s"(r0s_));
            const bf16_t* Qp = T.Q + (size_t)(r0s_ + qls) * 512 + (kvh * 4 + wid) * 64 + hi * 8;
#pragma unroll
            for (int ks = 0; ks < 4; ++ks) qn[ks] = *(const bf16x8*)(Qp + ks * 16); }
        const size_t orow = (size_t)(R0 + 32 * g + ql);
        if (prev_valid) wave_unit<true>(T, lds, qf, g, head, ql, r32, hi, lane, true, orow);
        else            wave_unit<false>(T, lds, qf, g, head, ql, r32, hi, lane, true, orow);
#pragma unroll
        for (int ks = 0; ks < 4; ++ks) qf[ks] = qn[ks];
    }
    asm volatile("s_waitcnt vmcnt(0)" ::: "memory");
    __syncthreads();
    {
        int t2 = threadIdx.x, blk2 = blk, kvh2 = kvh; asm volatile("" : "+v"(t2), "+s"(blk2), "+s"(kvh2));
        const int lane2 = t2 & 63, r2 = lane2 & 31, hi2 = lane2 >> 5, q2 = r2 < 4 ? r2 : 3;
        if (wid < 4) wave_unit<true>(T, lds, qf, 0, kvh2 * 4 + wid, q2, r2, hi2, lane2, r2 < 4, (size_t)(MP + blk2 * 4 + q2), IMG1);
        else if (wid < 6) sample_conv(T, blk2, kvh2, t2 - 256); }
    __syncthreads();
}
}

constexpr int NWAVES = 8;
#ifndef MK_N_LAUNCHES
#define MK_N_LAUNCHES 1
#endif
constexpr int NPHASE = 9;
constexpr int N_LAUNCHES = MK_N_LAUNCHES;
static_assert(N_LAUNCHES == 1 || N_LAUNCHES == NPHASE, "MK_N_LAUNCHES is 1 or 9");

constexpr size_t MiB = 1u << 20;
constexpr size_t WS_CTL = 0, CTL_ZERO_BYTES = 64 * 1024;
constexpr size_t WS_W1GU = 2 * MiB, WS_W1D = 13 * MiB, WS_WIN = 19 * MiB, WS_WOUT = 24 * MiB, WS_W2GU = 26 * MiB, WS_W2D = 37 * MiB, WS_WPG = 43 * MiB, WS_WPP = 45 * MiB;
constexpr size_t STATS_BYTES = (size_t)M * 16 * 4;
constexpr size_t WS_STATS = 46 * MiB;
constexpr size_t WS_RS0 = WS_STATS + 3 * STATS_BYTES;
constexpr size_t WS_CK = 50 * MiB, WS_CV = 54 * MiB;
constexpr size_t WS_PEB = 58 * MiB;
constexpr size_t WS_XB = 67 * MiB;
constexpr size_t WS_KB = 100 * MiB, WS_VB = 105 * MiB;
constexpr size_t WS_PP = 110 * MiB;
constexpr size_t WS_ACT = 143 * MiB;
constexpr size_t WS_QB = 143 * MiB, WS_GB = WS_QB + (size_t)M * 512 * 2, WS_UB = WS_GB + (size_t)M * 512 * 2, WS_MIX = WS_UB + (size_t)M * 512 * 2;
constexpr size_t WS_END = 234 * MiB;
static_assert(WS_W1GU + (size_t)2 * FF * D * 2 <= WS_W1D && WS_W1D + (size_t)D * FF * 2 <= WS_WIN && WS_WIN + (size_t)NIN * D * 2 <= WS_WOUT && WS_WOUT + (size_t)D * D * 2 <= WS_W2GU
              && WS_W2GU + (size_t)2 * FF * D * 2 <= WS_W2D && WS_W2D + (size_t)D * FF * 2 <= WS_WPG && WS_WPG + (size_t)D * D * 2 <= WS_WPP && WS_WPP + (size_t)D * DPLE * 2 <= WS_STATS
              && WS_RS0 + (size_t)M * 4 <= WS_CK && WS_PEB + (size_t)M * DPLE * 2 <= WS_XB && WS_XB + (size_t)M * D * 2 <= WS_KB && WS_KB + (size_t)M * 128 * 2 <= WS_VB
              && WS_VB + (size_t)M * 128 * 2 <= WS_PP && WS_PP + (size_t)M * D * 2 <= WS_ACT && WS_ACT + (size_t)M * FF * 2 <= WS_END && WS_MIX + (size_t)M * D * 2 <= WS_END, "d_ws map");
constexpr int CW_BAR = 4096;
constexpr size_t O_Y = 0, O_KWP = (size_t)M * D, O_VWP = O_KWP + 2 * 128 * 128, O_CVP = O_VWP + 2 * 128 * 128, O_KWS = O_CVP + 2 * 2 * 512, O_VWS = O_KWS + (size_t)128 * 128 * 128,
                 O_CVS = O_VWS + (size_t)128 * 128 * 128, O_END = O_CVS + 128 * 2 * 512;
constexpr int RING_OFF = 0, RING_BYTES = 131072;
constexpr int STAB_OFF = RING_BYTES, STAB_BYTES = 16384;
constexpr int STRIP_BYTES = 4096;
constexpr int LDSCTL_OFF = STAB_OFF + STAB_BYTES + STRIP_BYTES, MISC_OFF = LDSCTL_OFF + 320;
constexpr int LDS_BYTES = 153600;
static_assert(MISC_OFF + 128 <= LDS_BYTES, "LDS map");

struct Args { const float* in[26]; float* out; unsigned char* ws; int ph_lo, ph_hi, li, pad; };
typedef const __attribute__((address_space(4))) Args* KArgs;
__device__ __forceinline__ KArgs kargs() { KArgs p = (KArgs)__builtin_amdgcn_kernarg_segment_ptr(); asm volatile("" : "+s"(p)); return p; }
struct Frame {
    LAS unsigned char* lds;
    volatile LAS unsigned* MISC;
    gu32* ctl;
    int wave;
    int vcu, G;
};

__device__ __forceinline__ float wave_sum(float v) {
#pragma unroll
    for (int o = 1; o < 64; o <<= 1) v += __shfl_xor(v, o);
    return v;
}
__device__ __forceinline__ int map_swiglu(int n0, int up) { return 256 * (n0 >> 7) + 128 * up + (n0 & 127); }
__device__ __forceinline__ int map_in(int c0) {
    if (c0 < 512) { const int head = c0 >> 6, bj = (c0 >> 5) & 1; return 256 * (head >> 2) + 128 * bj + 32 * (head & 3); }
    if (c0 < 768) { const int t = c0 - 512, hv = t >> 6, bj = (t >> 5) & 1; return 512 + 128 * bj + 32 * hv; }
    if (c0 < 1280) return c0;
    if (c0 < 1792) { const int f = c0 - 1280; return 256 * (5 + (f >> 7)) + (f & 127); }
    { const int f = c0 - 1792; return 256 * (5 + (f >> 7)) + 128 + (f & 127); }
}
__device__ __forceinline__ int map_dst(int mode, int c0) { return mode == 0 ? c0 : mode == 1 ? map_swiglu(c0, 0) : mode == 2 ? map_swiglu(c0, 1) : map_in(c0); }
__device__ __forceinline__ void p0_transpose_item(const float* W, int N, const float* gain, bf16* WT, int KT, int mode, LAS unsigned* T, int k0, int n0, int lane) {
    const int a = lane & 15, b = lane >> 4;
    const float* src = W + (size_t)(k0 + 2 * b) * N + n0 + 4 * a;
    f32x4 va[8], vb[8];
#pragma unroll
    for (int j = 0; j < 8; ++j) { va[j] = *(const GAS f32x4*)(src + (size_t)(8 * j) * N); vb[j] = *(const GAS f32x4*)(src + (size_t)(8 * j + 1) * N); }
    const float wsc = mode == 1 ? LOG2E : mode == 2 ? (1.0f / LOG2E) : 1.0f;
#pragma unroll
    for (int j = 0; j < 8; ++j) { float ga = wsc, gb = wsc; if (gain) { ga = gain[k0 + 8 * j + 2 * b] * wsc; gb = gain[k0 + 8 * j + 2 * b + 1] * wsc; }
#pragma unroll
        for (int e = 0; e < 4; ++e) T[(4 * a + e) * 33 + 4 * j + b] = pk2(va[j][e] * ga, vb[j][e] * gb); }
    LDS_WAIT(); asm volatile("" ::: "memory");
#pragma unroll
    for (int jj = 0; jj < 8; ++jj) { const int n = 8 * jj + (lane >> 3), kc = lane & 7; const LAS unsigned* s = T + n * 33 + 4 * kc;
        v4u o; o.x = s[0]; o.y = s[1]; o.z = s[2]; o.w = s[3];
        const int drow = map_dst(mode, n0 + (n & 32)) + (n & 31);
        *(GAS v4u*)(WT + (size_t)drow * KT + k0 + 8 * kc) = o; }
    LDS_WAIT(); asm volatile("" ::: "memory");
}
__device__ __forceinline__ void p0_weights(Frame& F, KArgs Ap, int which, int gw, int NGW) {
    int tid_ = threadIdx.x; asm volatile("" : "+v"(tid_)); const int lane = tid_ & 63;
    unsigned char* ws = Ap->ws;
    LAS unsigned* scr = (LAS unsigned*)(F.lds + RING_OFF + F.wave * 16384);
    constexpr int I_GU = (D / 64) * (FF / 64), I_DN = (FF / 64) * (D / 64), I_IN = (D / 64) * (NIN / 64), I_SQ = (D / 64) * (D / 64), I_PP = (DPLE / 64) * (D / 64);
    constexpr int NITEMS = 4 * I_GU + 2 * I_DN + I_IN + 2 * I_SQ + I_PP;
    constexpr int B1 = 2 * I_GU, B3 = B1 + I_DN + I_IN + I_SQ + 2 * I_GU, B4 = B3 + I_DN + I_SQ;
    const int lo_ = which == 1 ? B1 : B3, n_ = which == 0 ? B1 + I_PP : which == 1 ? B3 - B1 : B4 - B3;
    for (int it0 = gw; it0 < n_; it0 += NGW) {
        int r = which == 0 ? (it0 < B1 ? it0 : it0 - B1 + B4) : lo_ + it0;
        const float* W; const float* gain = nullptr; bf16* WT; int K, N, mode;
        if (r < I_GU) { W = Ap->in[9]; WT = (bf16*)(ws + WS_W1GU); K = D; N = FF; mode = 1; }
        else if ((r -= I_GU) < I_GU) { W = Ap->in[10]; WT = (bf16*)(ws + WS_W1GU); K = D; N = FF; mode = 2; }
        else if ((r -= I_GU) < I_DN) { W = Ap->in[11]; WT = (bf16*)(ws + WS_W1D); K = FF; N = D; mode = 0; }
        else if ((r -= I_DN) < I_IN) { W = Ap->in[13]; gain = Ap->in[12]; WT = (bf16*)(ws + WS_WIN); K = D; N = NIN; mode = 3; }
        else if ((r -= I_IN) < I_SQ) { W = Ap->in[18]; WT = (bf16*)(ws + WS_WOUT); K = D; N = D; mode = 0; }
        else if ((r -= I_SQ) < I_GU) { W = Ap->in[20]; gain = Ap->in[19]; WT = (bf16*)(ws + WS_W2GU); K = D; N = FF; mode = 1; }
        else if ((r -= I_GU) < I_GU) { W = Ap->in[21]; gain = Ap->in[19]; WT = (bf16*)(ws + WS_W2GU); K = D; N = FF; mode = 2; }
        else if ((r -= I_GU) < I_DN) { W = Ap->in[22]; WT = (bf16*)(ws + WS_W2D); K = FF; N = D; mode = 0; }
        else if ((r -= I_DN) < I_SQ) { W = Ap->in[24]; gain = Ap->in[23]; WT = (bf16*)(ws + WS_WPG); K = D; N = D; mode = 0; }
        else { r -= I_SQ; W = Ap->in[25]; WT = (bf16*)(ws + WS_WPP); K = DPLE; N = D; mode = 0; }
        const int nblk = N / 64, kb = r / nblk, nb = r % nblk, k0 = 64 * kb, n0 = 64 * nb;
        p0_transpose_item(W, N, gain, WT, K, mode, scr, k0, n0, lane);
    }
}
__device__ __forceinline__ void p0_prologue(Frame& F, KArgs Ap) {
    const int tid0 = (int)threadIdx.x, lane0 = tid0 & 63;
    unsigned char* ws = Ap->ws;
    const int gw = F.vcu * NWAVES + F.wave, NGW = F.G * NWAVES;
    p0_weights(F, Ap, 0, gw, NGW);
    {
        const float* g1 = Ap->in[8]; bf16* XB = (bf16*)(ws + WS_XB);
        f32x4 gv[4];
#pragma unroll
        for (int j = 0; j < 4; ++j) gv[j] = ((const GAS f32x4*)g1)[64 * j + lane0];
        for (int m0 = gw; m0 < M; m0 += 2 * NGW) {
            f32x4 v[2][4];
#pragma unroll
            for (int q = 0; q < 2; ++q) { const int m = m0 + q * NGW; if (m < M) { const float* xrow = (m < MP) ? Ap->in[0] + (size_t)m * D : Ap->in[1] + (size_t)(m - MP) * D;
                const GAS f32x4* xr = (const GAS f32x4*)xrow + lane0;
#pragma unroll
                for (int j = 0; j < 4; ++j) v[q][j] = xr[64 * j]; } }
#pragma unroll
            for (int q = 0; q < 2; ++q) { const int m = m0 + q * NGW; if (m < M) { float s = 0.f;
#pragma unroll
                for (int j = 0; j < 4; ++j) s += (v[q][j].x * v[q][j].x + v[q][j].y * v[q][j].y) + (v[q][j].z * v[q][j].z + v[q][j].w * v[q][j].w);
                const float rms = sqrtf(wave_sum(s) * (1.f / D) + RMS_EPS), rstd = 1.f / rms;
                if (lane0 == 0) ((float*)(ws + WS_RS0))[m] = rms;
                GAS unsigned long long* o8 = (GAS unsigned long long*)(XB + (size_t)m * D) + lane0;
#pragma unroll
                for (int j = 0; j < 4; ++j) { const f32x4 o = v[q][j] * rstd * gv[j]; o8[64 * j] = (unsigned long long)pk2(o.x, o.y) | ((unsigned long long)pk2(o.z, o.w) << 32); } } }
        }
    }
    {
        const int gt = F.vcu * (NWAVES * 64) + tid0, NT = F.G * NWAVES * 64;
        for (int i = gt; i < 3 * MS * 16; i += NT) { const int k = i / (MS * 16), j = i - k * (MS * 16); ((float*)(ws + WS_STATS + (size_t)k * STATS_BYTES))[(size_t)MP * 16 + j] = 0.f; }
        bf16* PEB = (bf16*)(ws + WS_PEB);
        constexpr int NPE = M * DPLE / 8, NPEP = MP * DPLE / 8;
        for (int i = gt; i < NPE; i += NT) {
            const float* src = (i < NPEP) ? Ap->in[2] + (size_t)i * 8 : Ap->in[3] + (size_t)(i - NPEP) * 8;
            const f32x4 a = *(const GAS f32x4*)src, b = *(const GAS f32x4*)(src + 4);
            v4u o; o.x = pk2(a.x, a.y); o.y = pk2(a.z, a.w); o.z = pk2(b.x, b.y); o.w = pk2(b.z, b.w);
            *(GAS v4u*)(PEB + (size_t)i * 8) = o;
        }
        constexpr int NC = 128 * 128 * 128 / 8;
        for (int i = gt; i < 2 * NC; i += NT) {
            const int which = i >= NC, j = which ? i - NC : i;
            const float* src = Ap->in[4 + which] + (size_t)j * 8;
            const f32x4 a = *(const GAS f32x4*)src, b = *(const GAS f32x4*)(src + 4);
            v4u o; o.x = pk2(a.x, a.y); o.y = pk2(a.z, a.w); o.z = pk2(b.x, b.y); o.w = pk2(b.z, b.w);
            *(GAS v4u*)((bf16*)(ws + (which ? WS_CV : WS_CK)) + (size_t)j * 8) = o;
            const int w = (j >> 4) & 127;
            if (w >= 4) { float* dst = Ap->out + (which ? O_VWS : O_KWS) + (size_t)j * 8 - 512; *(GAS f32x4*)dst = a; *(GAS f32x4*)(dst + 4) = b; }
        }
    }
}

__constant__ unsigned char c_bucket[128] = {0, 1, 2, 3, 4, 5, 6, 7, 8, 9, 10, 11, 12, 13, 14, 15, 16, 16, 16, 17, 17, 18, 18, 18, 19, 19, 19, 20, 20, 20, 20, 21, 21, 21, 21, 22, 22, 22, 22, 22, 23, 23, 23, 23, 23, 23, 24, 24, 24, 24, 24, 24,
    25, 25, 25, 25, 25, 25, 25, 26, 26, 26, 26, 26, 26, 26, 26, 27, 27, 27, 27, 27, 27, 27, 27, 27, 27, 28, 28, 28, 28, 28, 28, 28, 28, 28, 28, 29, 29, 29, 29, 29, 29, 29, 29, 29, 29, 29, 29, 30, 30, 30, 30, 30, 30, 30, 30, 30, 30, 30, 30, 30, 30,
    31, 31, 31, 31, 31, 31, 31, 31, 31, 31, 31, 31, 31, 31, 31};

__global__ void __launch_bounds__(NWAVES * 64, 2) mk_fwd(Args args) {
    extern __shared__ __attribute__((aligned(16))) unsigned char lds[];
    Frame F;
    F.lds = (LAS unsigned char*)lds;
    F.MISC = (volatile LAS unsigned*)(F.lds + MISC_OFF);
    F.wave = __builtin_amdgcn_readfirstlane((int)threadIdx.x >> 6);
    F.G = gridDim.x; { const int bx = blockIdx.x; F.vcu = (F.G % 8 == 0) ? (bx % 8) * (F.G / 8) + bx / 8 : bx; }
    F.ctl = (gu32*)(args.ws + WS_CTL);
    for (int u = (int)threadIdx.x; u < (LDS_BYTES - LDSCTL_OFF) / 4; u += NWAVES * 64) ((LAS unsigned*)(F.lds + LDSCTL_OFF))[u] = 0u;
    __syncthreads();
    XcdBarrier bar; bar.bar = (unsigned*)(F.ctl + CW_BAR); bar.x = 0; bar.st = nullptr;
    if (N_LAUNCHES == 1) bar = xcd_barrier_post((unsigned*)(F.ctl + CW_BAR), F.MISC + 8);
#define GRID_BAR() do { if (N_LAUNCHES == 1) xcd_barrier(bar); } while (0)
    const int lo = args.ph_lo, hi = args.ph_hi;
#define IN(k) (lo <= (k) && (k) < hi)
#define BOTH(k) (IN(k) && IN((k) + 1))
#define PHASE_ARGS() KArgs KA = kargs(); unsigned char* const ws = KA->ws; float* const out = KA->out; (void)out; \
    bf16* const XB = (bf16*)(ws + WS_XB); bf16* const ACT = (bf16*)(ws + WS_ACT); bf16* const PP = (bf16*)(ws + WS_PP); (void)XB; (void)ACT; (void)PP; \
    float* const ST1 = (float*)(ws + WS_STATS); float* const ST2 = (float*)(ws + WS_STATS + STATS_BYTES); float* const ST3 = (float*)(ws + WS_STATS + 2 * STATS_BYTES); (void)ST1; (void)ST2; (void)ST3

    if (IN(0)) { p0_prologue(F, kargs()); if (BOTH(0)) GRID_BAR(); }

    if (IN(1)) { PHASE_ARGS();
        { pg8::Gemm g{XB, (const bf16*)(ws + WS_W1GU), M, 2 * FF, D}; pg8::StaticOrder S; S.init(M, 2 * FF, F.G, (int)blockIdx.x);
          pg8::EpiSwiglu<false> E{ACT, nullptr, nullptr};
          pg8::gemm_phase<pg8::EpiSwiglu<false>, pg8::StaticOrder, true, true>(F.lds + RING_OFF, g, S, E); }
        { constexpr int NU = (M / 256) * (2 * FF / 256), FIRST_IDLE = NU % 256;
          if (F.G == 256 && (int)blockIdx.x >= FIRST_IDLE) p0_weights(F, KA, 1, ((int)blockIdx.x - FIRST_IDLE) * NWAVES + F.wave, (256 - FIRST_IDLE) * NWAVES);
          else if (F.G != 256) p0_weights(F, KA, 1, F.vcu * NWAVES + F.wave, F.G * NWAVES); }
        if (BOTH(1)) GRID_BAR();
    }
    if (IN(2)) { PHASE_ARGS();
        pg8::Gemm g{ACT, (const bf16*)(ws + WS_W1D), MP, D, FF}; pg8::StaticOrder S; S.init(MP, D, F.G, (int)blockIdx.x);
        pg8::EpiResid<true> E{(const float*)(ws + WS_RS0), KA->in[8], XB, ST1, 0.5f};
        pg8::gemm_phase<pg8::EpiResid<true>, pg8::StaticOrder, true, true>(F.lds + RING_OFF, g, S, E);
        if (BOTH(2)) GRID_BAR();
    }
    if (IN(3)) { PHASE_ARGS();
        { pg8::Gemm g{XB, (const bf16*)(ws + WS_WIN), M, NIN, D}; pg8::StaticOrder S; S.init(M, NIN, F.G, (int)blockIdx.x);
        pg8::EpiIn E{ST1, F.lds + STAB_OFF, KA->in[14], KA->in[15], (bf16*)(ws + WS_QB), (bf16*)(ws + WS_KB), (bf16*)(ws + WS_VB), (bf16*)(ws + WS_GB), (bf16*)(ws + WS_UB),
                     out + O_KWP, out + O_VWP, out + O_CVP, out + O_KWS, out + O_VWS, out + O_CVS};
        pg8::gemm_phase<pg8::EpiIn, pg8::StaticOrder, true, true>(F.lds + RING_OFF, g, S, E); }
        { int kpp = DPLE; asm volatile("" : "+s"(kpp));
          pg8::Gemm g{(const bf16*)(ws + WS_PEB), (const bf16*)(ws + WS_WPP), M, D, kpp}; pg8::StaticOrder S; if (F.G == 256) { const int j = (int)blockIdx.x - 82; S.init(M, D, 174, j >= 0 ? j : (1 << 20)); } else S.init(M, D, F.G, (int)blockIdx.x);
          pg8::EpiStoreBf16 E{PP, D};
          pg8::gemm_phase<pg8::EpiStoreBf16, pg8::StaticOrder, true, true>(F.lds + RING_OFF, g, S, E); }
        if (BOTH(3)) GRID_BAR();
    }
    if (IN(4)) { PHASE_ARGS();
        { LAS float* bt = (LAS float*)(F.lds + att::L_BIAS); const float* relb = KA->in[7];
          for (int i = (int)threadIdx.x; i < 8 * att::BIASW; i += NWAVES * 64) { const int h = i / att::BIASW, d = i - h * att::BIASW - 32; bt[i] = (d >= 0 && d < 128) ? relb[c_bucket[d] * 8 + h] * LOG2E : 0.f; } }
        const att::Tensors T{(const bf16*)(ws + WS_QB), (const bf16*)(ws + WS_KB), (const bf16*)(ws + WS_VB), (const bf16*)(ws + WS_GB), (const bf16*)(ws + WS_UB), (const bf16*)(ws + WS_CK), (const bf16*)(ws + WS_CV),
                             (bf16*)(ws + WS_MIX), KA->in[17], KA->in[6], KA->in[16], KA->in[7]};
        if (F.G == 256) att::pair(T, F.lds, (int)blockIdx.x >> 1, (int)blockIdx.x & 1);
        else for (int i = blockIdx.x; i < 512; i += F.G) { const bool sample = i >= 256; const int j = i & 255; att::unit(T, F.lds, sample, j >> 1, j & 1); }
        if (BOTH(4)) GRID_BAR();
    }
    if (IN(5)) { PHASE_ARGS();
        pg8::Gemm g{(const bf16*)(ws + WS_MIX), (const bf16*)(ws + WS_WOUT), MP, D, D}; pg8::StaticOrder S; S.init(MP, D, F.G, (int)blockIdx.x);
        pg8::EpiResid<false> E{nullptr, nullptr, XB, ST2, 1.0f};
        pg8::gemm_phase<pg8::EpiResid<false>, pg8::StaticOrder, true, true>(F.lds + RING_OFF, g, S, E);
        if (BOTH(5)) GRID_BAR();
    }
    if (IN(6)) { PHASE_ARGS();
        pg8::Gemm g{XB, (const bf16*)(ws + WS_W2GU), M, 2 * FF, D}; pg8::StaticOrder S; S.init(M, 2 * FF, F.G, (int)blockIdx.x);
        pg8::EpiSwiglu<true> E{ACT, ST2, F.lds + STAB_OFF};
        pg8::gemm_phase<pg8::EpiSwiglu<true>, pg8::StaticOrder, true, true>(F.lds + RING_OFF, g, S, E);
        if (F.G == 256 && (int)blockIdx.x >= 172) p0_weights(F, KA, 2, ((int)blockIdx.x - 172) * NWAVES + F.wave, 84 * NWAVES);
        else if (F.G != 256) p0_weights(F, KA, 2, F.vcu * NWAVES + F.wave, F.G * NWAVES);
        if (BOTH(6)) GRID_BAR();
    }
    if (IN(7)) { PHASE_ARGS();
        pg8::Gemm g{ACT, (const bf16*)(ws + WS_W2D), MP, D, FF}; pg8::StaticOrder S; S.init(MP, D, F.G, (int)blockIdx.x);
        pg8::EpiResid<false> E{nullptr, nullptr, XB, ST3, 0.5f};
        pg8::gemm_phase<pg8::EpiResid<false>, pg8::StaticOrder, true, true>(F.lds + RING_OFF, g, S, E);
        if (BOTH(7)) GRID_BAR();
    }
    if (IN(8)) { PHASE_ARGS();
        pg8::Gemm g{XB, (const bf16*)(ws + WS_WPG), MP, D, D}; pg8::StaticOrder S; S.init(MP, D, F.G, (int)blockIdx.x);
        pg8::EpiPle E{ST3, F.lds + STAB_OFF, PP, XB, out};
        pg8::gemm_phase<pg8::EpiPle, pg8::StaticOrder, true, true>(F.lds + RING_OFF, g, S, E);
    }
#undef IN
#undef BOTH
#undef GRID_BAR
#undef PHASE_ARGS
}

extern "C" void kernel_launch(void* const* d_in, const int* in_sizes, int n_in, void* d_out, int out_size, void* d_ws, size_t ws_size, hipStream_t stream) {
    static int grid = 0;
    if (grid == 0) {
        if (n_in != 26 || in_sizes[0] != MP * D || (size_t)out_size != O_END || ws_size < WS_END) { fprintf(stderr, "kernel_launch: unexpected shapes: n_in %d, in0 %d, out %d, ws %zu; nothing launched\n", n_in, n_in > 0 ? in_sizes[0] : -1, out_size, ws_size); grid = -1; return; }
        int dev = 0, cus = 0, per_cu = 0;
        if (hipGetDevice(&dev) != hipSuccess || hipDeviceGetAttribute(&cus, hipDeviceAttributeMultiprocessorCount, dev) != hipSuccess) { fprintf(stderr, "kernel_launch: hipGetDevice / hipDeviceGetAttribute failed\n"); grid = -1; return; }
        if (hipFuncSetAttribute((const void*)mk_fwd, hipFuncAttributeMaxDynamicSharedMemorySize, LDS_BYTES) != hipSuccess) { fprintf(stderr, "kernel_launch: hipFuncSetAttribute failed\n"); grid = -1; return; }
        if (hipOccupancyMaxActiveBlocksPerMultiprocessor(&per_cu, (const void*)mk_fwd, NWAVES * 64, LDS_BYTES) != hipSuccess || per_cu < 1)
            fprintf(stderr, "kernel_launch: note: the occupancy query reports %d workgroups per CU\n", per_cu);
        (void)hipGetLastError();
        grid = cus;
    }
    if (grid < 0) return;
    if (hipMemsetAsync((char*)d_ws + WS_CTL, 0, CTL_ZERO_BYTES, stream) != hipSuccess) { fprintf(stderr, "kernel_launch: hipMemsetAsync failed\n"); return; }
    Args a{};
    for (int i = 0; i < 26; ++i) a.in[i] = (const float*)d_in[i];
    a.out = (float*)d_out; a.ws = (unsigned char*)d_ws;
    for (int li = 0; li < N_LAUNCHES; ++li) {
        a.ph_lo = (N_LAUNCHES == 1) ? 0 : li; a.ph_hi = (N_LAUNCHES == 1) ? NPHASE : li + 1; a.li = li;
        hipLaunchKernelGGL(mk_fwd, dim3(grid), dim3(NWAVES * 64), LDS_BYTES, stream, a);
        const hipError_t le = hipPeekAtLastError();
        if (le != hipSuccess) { fprintf(stderr, "kernel_launch: launch %d failed: %s\n", li, hipGetErrorName(le)); break; }
    }
}
```
